# Optimizing an MI355X kernel written in HIP

```python
import jax, jax.numpy as jnp
from jax import lax
import numpy as np

D_MODEL = 2048
BATCH = 32
SEQ = 256
DEPTH = 4
DEC_BATCH = 2
DEC_SEQ = 2048
PAST_LEN = 256

GRID_W = 64
HEAD_DIM = 128
POOL_GROUPS = 4
POOL_WIDTH = D_MODEL // 4
POOL_WINDOWS = (2, 4, 8, 16)
B_Q_HEADS = (D_MODEL - POOL_WIDTH) // HEAD_DIM
B_KV_HEADS = B_Q_HEADS // 3
D_WIDTH = D_MODEL // 4
C_HEADS = (D_MODEL - D_WIDTH) // HEAD_DIM
CONV_WIDTH = 3
NA_KH = 8
NA_KW = 16
FFN_HIDDEN = -(-8 * D_MODEL // (3 * 256)) * 256
AB_IN = POOL_WIDTH + (B_Q_HEADS + 2 * B_KV_HEADS) * HEAD_DIM
CD_IN = 3 * C_HEADS * HEAD_DIM + 3 * D_WIDTH
MIX_OUT = D_MODEL
N_EVEN = (DEPTH + 1) // 2
N_ODD = DEPTH // 2
ALPHA = (2 * DEPTH) ** 0.25
BETA = (8 * DEPTH) ** -0.25
ROPE_THETA = 10000.0
LN_EPS = 1e-5
RMS_EPS = 1e-6
Q_BLOCK = 128

kernel_name = 'hybrid_flow_pool_gqa_natten_shortconv_step'


def layer_norm(x, g, b):
    xf = x.astype(jnp.float32)
    mu = jnp.mean(xf, axis=-1, keepdims=True)
    var = jnp.mean(jnp.square(xf - mu), axis=-1, keepdims=True)
    return ((xf - mu) * lax.rsqrt(var + LN_EPS) * g + b).astype(x.dtype)


def rms_norm_heads(x, g):
    xf = x.astype(jnp.float32)
    return (xf * lax.rsqrt(jnp.mean(xf * xf, axis=-1, keepdims=True) + RMS_EPS) * g).astype(x.dtype)


def adaln(cond, w_ada, b_ada):
    m = (jax.nn.silu(cond) @ w_ada + b_ada)[:, None, :]
    return jnp.split(m, 6, axis=-1)


def modulate(x, shift, scale):
    return x * (1 + scale) + shift


def axial_rope_tables(n_tokens):
    t = jnp.arange(n_tokens)
    row = (t // GRID_W).astype(jnp.float32)
    col = (t % GRID_W).astype(jnp.float32)
    half = HEAD_DIM // 2
    inv = 1.0 / (ROPE_THETA ** (jnp.arange(0, half, 2, dtype=jnp.float32) / half))
    ang = jnp.concatenate([row[:, None] * inv, col[:, None] * inv], axis=-1)
    return jnp.cos(ang), jnp.sin(ang)


def apply_rope(x, cos, sin):
    xf = x.astype(jnp.float32)
    half = HEAD_DIM // 2
    x1, x2 = xf[..., :half], xf[..., half:]
    c = cos[None, :, None, :]
    s = sin[None, :, None, :]
    return jnp.concatenate([x1 * c - x2 * s, x2 * c + x1 * s], axis=-1).astype(x.dtype)


def blocked_attention(q, k, v):
    b, L, hq, d = q.shape
    hkv = k.shape[2]
    g = hq // hkv
    nb = L // Q_BLOCK
    qb = jnp.moveaxis(q.reshape(b, nb, Q_BLOCK, hkv, g, d), 1, 0)
    scale = d ** -0.5

    def one_block(qblk):
        s = jnp.einsum('bqhgd,bkhd->bhgqk', qblk, k, preferred_element_type=jnp.float32) * scale
        p = jax.nn.softmax(s, axis=-1).astype(v.dtype)
        return jnp.einsum('bhgqk,bkhd->bqhgd', p, v)

    o = lax.map(one_block, qb)
    return jnp.moveaxis(o, 0, 1).reshape(b, L, hq, d)


def neighborhood_attention(q, k, v, ctx_k, ctx_v, rpb):
    b, L, h, d = q.shape
    rows = L // GRID_W
    kh = min(NA_KH, rows)
    kw = NA_KW
    r = jnp.arange(rows)
    row_start = jnp.clip(r - kh // 2, 0, rows - kh)
    row_idx = row_start[:, None] + jnp.arange(kh)[None, :]
    nk = kh * GRID_W
    qg = q.reshape(b, rows, GRID_W, h, d)
    band_k = k.reshape(b, rows, GRID_W, h, d)[:, row_idx].reshape(b, rows, nk, h, d)
    band_v = v.reshape(b, rows, GRID_W, h, d)[:, row_idx].reshape(b, rows, nk, h, d)
    scale = d ** -0.5
    s_nb = jnp.einsum('brqhd,brkhd->bhrqk', qg, band_k, preferred_element_type=jnp.float32) * scale
    col = jnp.arange(GRID_W)
    col_start = jnp.clip(col - kw // 2, 0, GRID_W - kw)
    col_ok = (col[None, :] >= col_start[:, None]) & (col[None, :] < col_start[:, None] + kw)
    mask = jnp.broadcast_to(col_ok[:, None, :], (GRID_W, kh, GRID_W)).reshape(GRID_W, nk)
    dr_idx = (row_idx - r[:, None]) + NA_KH - 1
    dc_idx = jnp.clip(col[None, :] - col[:, None], -(kw - 1), kw - 1) + kw - 1
    bias = rpb[:, dr_idx[:, None, :, None], dc_idx[None, :, None, :]].reshape(h, rows, GRID_W, nk)
    s_nb = jnp.where(mask, s_nb + bias[None].astype(jnp.float32), -jnp.inf)
    s_ctx = jnp.einsum('brqhd,bkhd->bhrqk', qg, ctx_k, preferred_element_type=jnp.float32) * scale
    p = jax.nn.softmax(jnp.concatenate([s_nb, s_ctx], axis=-1), axis=-1).astype(v.dtype)
    o = (jnp.einsum('bhrqk,brkhd->brqhd', p[..., :nk], band_v)
         + jnp.einsum('bhrqk,bkhd->brqhd', p[..., nk:], ctx_v))
    return o.reshape(b, L, h, d)


def multiscale_pool(u, pool_w, pool_scale):
    b, L, _ = u.shape
    cw = POOL_WIDTH // POOL_GROUPS
    ug = u.reshape(b, L, POOL_GROUPS, cw)
    csum = jnp.cumsum(ug.astype(jnp.float32), axis=1)
    csum = jnp.concatenate([jnp.zeros_like(csum[:, :1]), csum], axis=1)
    t = jnp.arange(L)[:, None]
    w = jnp.array(POOL_WINDOWS, dtype=jnp.int32)[None, :]
    lo = jnp.clip(t - w // 2, 0, L - 1)
    hi = jnp.clip(t - w // 2 + w - 1, 0, L - 1)
    gidx = jnp.arange(POOL_GROUPS)[None, :]
    window_sum = csum[:, hi + 1, gidx] - csum[:, lo, gidx]
    mean = window_sum / (hi - lo + 1).astype(jnp.float32)[None, :, :, None]
    pooled = (mean - ug.astype(jnp.float32)).astype(u.dtype)
    y = jnp.einsum('blgc,gcd->blgd', pooled, pool_w)
    return y.reshape(b, L, POOL_WIDTH) * pool_scale


def short_gated_conv(xin, gb, gc, conv_w):
    u = gc * xin
    up = jnp.pad(u, ((0, 0), (1, 1), (0, 0)))
    y = conv_w[0] * up[:, :-2] + conv_w[1] * up[:, 1:-1] + conv_w[2] * up[:, 2:]
    return gb * y


def mixer_ab(h, w_in, w_out, pool_w, pool_scale, q_g, k_g, rope=None, ctx_k=None, ctx_v=None):
    b, L, _ = h.shape
    proj = h @ w_in
    s1 = POOL_WIDTH
    s2 = s1 + B_Q_HEADS * HEAD_DIM
    s3 = s2 + B_KV_HEADS * HEAD_DIM
    u, q, k, v = jnp.split(proj, [s1, s2, s3], axis=-1)
    q = rms_norm_heads(q.reshape(b, L, B_Q_HEADS, HEAD_DIM), q_g)
    k = rms_norm_heads(k.reshape(b, L, B_KV_HEADS, HEAD_DIM), k_g)
    v = v.reshape(b, L, B_KV_HEADS, HEAD_DIM)
    pool_out = multiscale_pool(u, pool_w, pool_scale)
    if ctx_k is None:
        attn = blocked_attention(q, k, v)
    else:
        cos, sin = rope
        qr = apply_rope(q, cos, sin)
        kr = apply_rope(k, cos, sin)
        attn = blocked_attention(qr, jnp.concatenate([kr, ctx_k], axis=1), jnp.concatenate([v, ctx_v], axis=1))
    out = jnp.concatenate([pool_out, attn.reshape(b, L, B_Q_HEADS * HEAD_DIM)], axis=-1) @ w_out
    return out, k, v


def mixer_cd(h, w_in, w_out, rpb, conv_w, ctx_k=None, ctx_v=None):
    b, L, _ = h.shape
    cw = C_HEADS * HEAD_DIM
    proj = h @ w_in
    q, k, v, xin, gb, gc = jnp.split(proj, [cw, 2 * cw, 3 * cw, 3 * cw + D_WIDTH, 3 * cw + 2 * D_WIDTH], axis=-1)
    q = q.reshape(b, L, C_HEADS, HEAD_DIM)
    k = k.reshape(b, L, C_HEADS, HEAD_DIM)
    v = v.reshape(b, L, C_HEADS, HEAD_DIM)
    if ctx_k is None:
        attn = blocked_attention(q, k, v)
    else:
        attn = neighborhood_attention(q, k, v, ctx_k, ctx_v, rpb)
    conv_out = short_gated_conv(xin, gb, gc, conv_w)
    out = jnp.concatenate([attn.reshape(b, L, cw), conv_out], axis=-1) @ w_out
    return out, k, v


def swiglu(h, wg, wu, wd):
    return (jax.nn.silu(h @ wg) * (h @ wu)) @ wd


def setup_inputs(seed: int = 0) -> dict:
    key = jax.random.key(seed)
    ks = jax.random.split(key, 32)

    def nrm(k, shape, scale=1.0):
        return jax.random.normal(k, shape, jnp.float32) * scale

    kvb = (DEC_BATCH, PAST_LEN, B_KV_HEADS, HEAD_DIM)
    kvc = (DEC_BATCH, PAST_LEN, C_HEADS, HEAD_DIM)
    return {
        'x_prompt': nrm(ks[0], (BATCH, SEQ, D_MODEL)),
        'x_sample': nrm(ks[1], (DEC_BATCH, DEC_SEQ, D_MODEL)),
        'cache_k_l0': nrm(ks[2], kvb),
        'cache_v_l0': nrm(ks[3], kvb),
        'cache_k_l1': nrm(ks[4], kvc),
        'cache_v_l1': nrm(ks[5], kvc),
        'cache_k_l2': nrm(ks[6], kvb),
        'cache_v_l2': nrm(ks[7], kvb),
        'cache_k_l3': nrm(ks[8], kvc),
        'cache_v_l3': nrm(ks[9], kvc),
        'c': nrm(ks[10], (DEC_BATCH, D_MODEL)),
        'c_ctx': nrm(ks[11], (D_MODEL,)),
        'w_ada': nrm(ks[12], (DEPTH, D_MODEL, 6 * D_MODEL), 0.5 * D_MODEL ** -0.5),
        'b_ada': nrm(ks[13], (DEPTH, 6 * D_MODEL), 0.01),
        'ln1_g': 1.0 + nrm(ks[14], (DEPTH, D_MODEL), 0.05),
        'ln1_b': nrm(ks[15], (DEPTH, D_MODEL), 0.02),
        'ln2_g': 1.0 + nrm(ks[16], (DEPTH, D_MODEL), 0.05),
        'ln2_b': nrm(ks[17], (DEPTH, D_MODEL), 0.02),
        'w_in_ab': nrm(ks[18], (N_EVEN, D_MODEL, AB_IN), D_MODEL ** -0.5),
        'w_out_ab': nrm(ks[19], (N_EVEN, MIX_OUT, D_MODEL), BETA * MIX_OUT ** -0.5),
        'pool_w': nrm(ks[20], (N_EVEN, POOL_GROUPS, POOL_WIDTH // POOL_GROUPS, POOL_WIDTH // POOL_GROUPS), (POOL_WIDTH // POOL_GROUPS) ** -0.5),
        'pool_scale': 1.0 + nrm(ks[21], (N_EVEN, POOL_WIDTH), 0.1),
        'q_norm_g': 1.0 + nrm(ks[22], (N_EVEN, HEAD_DIM), 0.05),
        'k_norm_g': 1.0 + nrm(ks[23], (N_EVEN, HEAD_DIM), 0.05),
        'w_in_cd': nrm(ks[24], (N_ODD, D_MODEL, CD_IN), D_MODEL ** -0.5),
        'w_out_cd': nrm(ks[25], (N_ODD, MIX_OUT, D_MODEL), BETA * MIX_OUT ** -0.5),
        'na_rpb': nrm(ks[26], (N_ODD, C_HEADS, 2 * NA_KH - 1, 2 * NA_KW - 1), 0.1),
        'conv_w': nrm(ks[27], (N_ODD, CONV_WIDTH, D_WIDTH), CONV_WIDTH ** -0.5),
        'w_ffn_gate': nrm(ks[28], (DEPTH, D_MODEL, FFN_HIDDEN), D_MODEL ** -0.5),
        'w_ffn_up': nrm(ks[29], (DEPTH, D_MODEL, FFN_HIDDEN), D_MODEL ** -0.5),
        'w_ffn_down': nrm(ks[30], (DEPTH, FFN_HIDDEN, D_MODEL), BETA * FFN_HIDDEN ** -0.5),
    }


def reference(x_prompt, x_sample, cache_k_l0, cache_v_l0, cache_k_l1, cache_v_l1, cache_k_l2, cache_v_l2,
              cache_k_l3, cache_v_l3, c, c_ctx, w_ada, b_ada, ln1_g, ln1_b, ln2_g, ln2_b,
              w_in_ab, w_out_ab, pool_w, pool_scale, q_norm_g, k_norm_g,
              w_in_cd, w_out_cd, na_rpb, conv_w, w_ffn_gate, w_ffn_up, w_ffn_down):
    caches = [(cache_k_l0, cache_v_l0), (cache_k_l1, cache_v_l1), (cache_k_l2, cache_v_l2), (cache_k_l3, cache_v_l3)]
    rope = axial_rope_tables(x_sample.shape[1])
    xp, xs = x_prompt, x_sample
    new_state = []
    for i in range(DEPTH):
        j = i // 2
        sh1_p, sc1_p, g1_p, sh2_p, sc2_p, g2_p = adaln(c_ctx[None, :], w_ada[i], b_ada[i])
        sh1_s, sc1_s, g1_s, sh2_s, sc2_s, g2_s = adaln(c, w_ada[i], b_ada[i])
        hp = modulate(xp, sh1_p, sc1_p)
        hs = modulate(xs, sh1_s, sc1_s)
        ck, cv = caches[i]
        if i % 2 == 0:
            op, kp, vp = mixer_ab(hp, w_in_ab[j], w_out_ab[j], pool_w[j], pool_scale[j], q_norm_g[j], k_norm_g[j])
            os_, _, _ = mixer_ab(hs, w_in_ab[j], w_out_ab[j], pool_w[j], pool_scale[j], q_norm_g[j], k_norm_g[j],
                                 rope=rope, ctx_k=ck, ctx_v=cv)
        else:
            op, kp, vp = mixer_cd(hp, w_in_cd[j], w_out_cd[j], na_rpb[j], conv_w[j])
            os_, _, _ = mixer_cd(hs, w_in_cd[j], w_out_cd[j], na_rpb[j], conv_w[j], ctx_k=ck, ctx_v=cv)
        new_state.append(kp)
        new_state.append(vp)
        xp = layer_norm(ALPHA * xp + g1_p * op, ln1_g[i], ln1_b[i])
        xs = layer_norm(ALPHA * xs + g1_s * os_, ln1_g[i], ln1_b[i])
        fp = swiglu(modulate(xp, sh2_p, sc2_p), w_ffn_gate[i], w_ffn_up[i], w_ffn_down[i])
        fs = swiglu(modulate(xs, sh2_s, sc2_s), w_ffn_gate[i], w_ffn_up[i], w_ffn_down[i])
        xp = layer_norm(ALPHA * xp + g2_p * fp, ln2_g[i], ln2_b[i])
        xs = layer_norm(ALPHA * xs + g2_s * fs, ln2_g[i], ln2_b[i])
    return (xp, xs, *new_state)
```

```cpp
#include <hip/hip_runtime.h>
#include <cstdio>
#include <cstdint>

#ifndef MK_PER_PHASE
#define MK_PER_PHASE 1
#endif

constexpr int DM = 2048, NCTX = 8192, NLAT = 4096, MTOK = NCTX + NLAT, FFH = 5632, NGU = 2 * FFH;
constexpr int LSEQ = 2048, PAST = 256, LKV = LSEQ + PAST;
constexpr int AB_IN = 3072, CD_IN = 6144;
constexpr float ALPHA_RES = 1.6817928305074292f;
constexpr float LN_EPS = 1e-5f, RMS_EPS = 1e-6f;
namespace pg8 {
#define PG8_LAS __attribute__((address_space(3)))
typedef unsigned short bf16_t;
typedef short bf16x8 __attribute__((ext_vector_type(8)));
typedef float f32x4 __attribute__((ext_vector_type(4)));
typedef unsigned u32x4 __attribute__((ext_vector_type(4)));
constexpr int BM = 256, BK = 64, HALF = 128, HTB = HALF * BK * 2  , STAGE_BYTES = 8 * HTB, NXCD = 8, WGM = 8;

__host__ __device__ __forceinline__ int lds_byte(int r, int c) { const int st = (r >> 4) * 2 + (c >> 5), rr = r & 15, cc = c & 31, ob = rr * 64 + cc * 2; return st * 1024 + (ob ^ (((ob >> 9) & 1) << 5)); }
__host__ __device__ __forceinline__ void stage_rc(int b, int& R, int& C) { const int st = b / 1024, sb = b % 1024, swz = sb ^ (((sb >> 9) & 1) << 5); R = (st >> 1) * 16 + swz / 64; C = (st & 1) * 32 + (swz % 64) / 2; }
__host__ __device__ __forceinline__ int perm32(int rho) { const int n = rho >> 4, i = rho & 15; return 8 * (i >> 2) + 4 * n + (i & 3); }

struct Unit { int pm, pn; };
struct Gemm { const bf16_t* A; const bf16_t* Bt; int M, N, K; };

struct StaticOrder {
    int nM, nN, nwg, G, c;
    __host__ __device__ void init(int M, int N, int G_, int c_) { nM = M / BM; nN = N / BM; nwg = nM * nN; G = G_; c = c_; }
    __host__ __device__ bool next(int i, Unit& u) const {
        const long L = (long)i * G + c; if (L >= nwg) return false;
        int wgid = (int)L; { const int q = nwg / NXCD, r = nwg % NXCD, xcd = wgid % NXCD, off = wgid / NXCD; wgid = (xcd < r ? xcd * (q + 1) : r * (q + 1) + (xcd - r) * q) + off; }
        const int nig = WGM * nN, gid = wgid / nig, fm = gid * WGM, gsz = (nM - fm) < WGM ? (nM - fm) : WGM;
        u.pm = fm + ((wgid % nig) % gsz); u.pn = (wgid % nig) / gsz; return true;
    }
    __device__ __forceinline__ void a_ready(const Unit&) const {}
    __device__ __forceinline__ void done(const Unit&) const {}
};

__device__ __forceinline__ unsigned cvt_pk_bf16(float lo, float hi) { unsigned r; asm volatile("v_cvt_pk_bf16_f32 %0, %1, %2" : "=v"(r) : "v"(lo), "v"(hi)); return r; }
typedef float f32x2 __attribute__((ext_vector_type(2)));

__device__ __forceinline__ int panel_cond(int pm) { return pm < 32 ? 0 : (pm < 40 ? 1 : 2); }

struct EpiProj {
    static constexpr bool PERM = true, AFTER_DRAIN = false;
    bf16_t* O; int ldc; int lo, mid, hi; bf16_t* R0; bf16_t* R1; int rld; float* F0; float* F1;
    __device__ __forceinline__ void operator()(const f32x4 (&acc)[2][2][4][2], const Unit& u, int wr, int wc, int fr, int fq) const {
        const int colt = u.pn * BM, cl = wc * 32 + 8 * fq, rl = wr * 64 + fr;
        const bool inr = colt >= lo && colt < hi; const int t = (colt >= mid) ? 1 : 0; const int cbase = colt - (t ? mid : lo);
        if (inr && u.pm >= 32) {
            bf16_t* R = t ? R1 : R0; const int lb = (u.pm - 32) >> 3, t0 = ((u.pm - 32) & 7) * 256;
            bf16_t* base = R + (size_t)(lb * 2304 + t0 + rl) * rld + cbase + cl;
#pragma unroll
            for (int ai = 0; ai < 2; ++ai)
#pragma unroll
                for (int m = 0; m < 4; ++m) { bf16_t* rowp = base + (size_t)(ai * HALF + m * 16) * rld;
#pragma unroll
                    for (int bj = 0; bj < 2; ++bj) { const f32x4 v0 = acc[ai][bj][m][0], v1 = acc[ai][bj][m][1];
                        u32x4 w; w.x = cvt_pk_bf16(v0[0], v0[1]); w.y = cvt_pk_bf16(v0[2], v0[3]); w.z = cvt_pk_bf16(v1[0], v1[1]); w.w = cvt_pk_bf16(v1[2], v1[3]);
                        *(u32x4*)(rowp + bj * HALF) = w; } }
        } else {
            bf16_t* base = O + (size_t)(u.pm * BM + rl) * ldc + colt + cl;
#pragma unroll
            for (int ai = 0; ai < 2; ++ai)
#pragma unroll
                for (int m = 0; m < 4; ++m) { bf16_t* rowp = base + (size_t)(ai * HALF + m * 16) * ldc;
#pragma unroll
                    for (int bj = 0; bj < 2; ++bj) { const f32x4 v0 = acc[ai][bj][m][0], v1 = acc[ai][bj][m][1];
                        u32x4 w; w.x = cvt_pk_bf16(v0[0], v0[1]); w.y = cvt_pk_bf16(v0[2], v0[3]); w.z = cvt_pk_bf16(v1[0], v1[1]); w.w = cvt_pk_bf16(v1[2], v1[3]);
                        *(u32x4*)(rowp + bj * HALF) = w; } }
            float* Fp = t ? F1 : F0;
            if (inr && Fp) {
                float* fb = Fp + (size_t)(u.pm * BM + rl) * rld + cbase + cl;
#pragma unroll
                for (int ai = 0; ai < 2; ++ai)
#pragma unroll
                    for (int m = 0; m < 4; ++m) { float* rowp = fb + (size_t)(ai * HALF + m * 16) * rld;
#pragma unroll
                        for (int bj = 0; bj < 2; ++bj) { *(f32x4*)(rowp + bj * HALF) = acc[ai][bj][m][0]; *(f32x4*)(rowp + bj * HALF + 4) = acc[ai][bj][m][1]; } }
            }
        }
    }
};

struct EpiRes {
    static constexpr bool PERM = false, AFTER_DRAIN = false;
    const float* XA; const float* XB; float* Y; const float* gate; float alpha;
    __device__ __forceinline__ void operator()(const f32x4 (&acc)[2][2][4][2], const Unit& u, int wr, int wc, int fr, int fq) const {
        const float* gv = gate + panel_cond(u.pm) * 12288;
        const float* Xp = (u.pm < 32) ? XA + (size_t)(u.pm * BM) * 2048 : XB + (size_t)((u.pm - 32) * BM) * 2048;
        float* Yp = Y + (size_t)(u.pm * BM) * 2048;
        const int r0 = wr * 64 + fr, col0 = u.pn * BM + wc * 32 + 4 * fq;
        f32x4 g4[2][2];
#pragma unroll
        for (int bj = 0; bj < 2; ++bj)
#pragma unroll
            for (int n = 0; n < 2; ++n) g4[bj][n] = *(const f32x4*)(gv + col0 + bj * HALF + n * 16);
#pragma unroll
        for (int ai = 0; ai < 2; ++ai)
#pragma unroll
            for (int m = 0; m < 4; ++m) { const size_t off = (size_t)(r0 + ai * HALF + m * 16) * 2048 + col0;
#pragma unroll
                for (int bj = 0; bj < 2; ++bj)
#pragma unroll
                    for (int n = 0; n < 2; ++n) { const f32x4 x = *(const f32x4*)(Xp + off + bj * HALF + n * 16);
                        *(f32x4*)(Yp + off + bj * HALF + n * 16) = x * alpha + g4[bj][n] * acc[ai][bj][m][n]; }
                asm volatile("" ::: "memory"); }
    }
};

struct EpiGU {
    static constexpr bool PERM = true, AFTER_DRAIN = false;
    bf16_t* ACT;
    static __device__ __forceinline__ float silu_mul(float g, float up) { const float e = __builtin_amdgcn_exp2f(g * -1.4426950408889634f); return g * __builtin_amdgcn_rcpf(1.0f + e) * up; }
    __device__ __forceinline__ void operator()(const f32x4 (&acc)[2][2][4][2], const Unit& u, int wr, int wc, int fr, int fq) const {
        bf16_t* base = ACT + (size_t)(u.pm * BM + wr * 64 + fr) * 5632 + u.pn * HALF + wc * 32 + 8 * fq;
#pragma unroll
        for (int ai = 0; ai < 2; ++ai)
#pragma unroll
            for (int m = 0; m < 4; ++m) { const f32x4 g0 = acc[ai][0][m][0], g1 = acc[ai][0][m][1], u0 = acc[ai][1][m][0], u1 = acc[ai][1][m][1];
                u32x4 w; w.x = cvt_pk_bf16(silu_mul(g0[0], u0[0]), silu_mul(g0[1], u0[1])); w.y = cvt_pk_bf16(silu_mul(g0[2], u0[2]), silu_mul(g0[3], u0[3]));
                w.z = cvt_pk_bf16(silu_mul(g1[0], u1[0]), silu_mul(g1[1], u1[1])); w.w = cvt_pk_bf16(silu_mul(g1[2], u1[2]), silu_mul(g1[3], u1[3]));
                *(u32x4*)(base + (size_t)(ai * HALF + m * 16) * 5632) = w; }
    }
};

template <class Epi, class Sched, bool ALIGN_EPI = false, bool SP2 = false>
__device__ __forceinline__ void gemm_phase(PG8_LAS unsigned char* lds, const Gemm g, const Sched& S, const Epi& E) {
    int tid = threadIdx.x; asm volatile("" : "+v"(tid));
    const int wid = __builtin_amdgcn_readfirstlane(tid >> 6), lane = tid & 63, wr = wid >> 2, wc = wid & 3, fr = lane & 15, fq = lane >> 4;
    const int K = g.K, nt = K / BK;
    unsigned voffA[2], voffB[2];
#pragma unroll
    for (int i = 0; i < 2; ++i) { int R, C; stage_rc(tid * 16 + i * 8192, R, C); const int Rb = Epi::PERM ? ((R & ~31) + perm32(R & 31)) : R;
        voffA[i] = (unsigned)(R * K + C) * 2u; voffB[i] = (unsigned)(Rb * K + C) * 2u; }
    const size_t kstep = (size_t)(BK * 2);
    const size_t hstep = (size_t)HALF * K * 2;
    const size_t tstep = 2 * hstep;
    const unsigned ldsw = (unsigned)wid * 1024u;
    const int aoff = lds_byte(wr * 64 + fr, fq * 8), boff = lds_byte(wc * 32 + fr, fq * 8);
#define PG8_SA(b, h) (((b) * 2 + (h)) * HTB)
#define PG8_SB(b, h) ((4 + (b) * 2 + (h)) * HTB)
#define PG8_STAGE(bufoff, gbase, voff) do { _Pragma("unroll") for (int _i = 0; _i < 2; ++_i) \
        __builtin_amdgcn_global_load_lds((const unsigned*)((const char*)(gbase) + (voff)[_i]), (PG8_LAS unsigned*)(lds + (bufoff) + ldsw + _i * 8192), 16, 0, 0); } while (0)
#define PG8_LDA(dst, b, h) do { _Pragma("unroll") for (int m = 0; m < 4; ++m) _Pragma("unroll") for (int k = 0; k < 2; ++k) dst[m][k] = *(const PG8_LAS bf16x8*)(lds + PG8_SA(b, h) + aoff + m * 2048 + k * 1024); } while (0)
#define PG8_LDB(dst, b, h) do { _Pragma("unroll") for (int n = 0; n < 2; ++n) _Pragma("unroll") for (int k = 0; k < 2; ++k) dst[n][k] = *(const PG8_LAS bf16x8*)(lds + PG8_SB(b, h) + boff + n * 2048 + k * 1024); } while (0)
#define PG8_MMA(ai, bj, At, Bt) do { __builtin_amdgcn_s_setprio(1); _Pragma("unroll") for (int m = 0; m < 4; ++m) _Pragma("unroll") for (int n = 0; n < 2; ++n) _Pragma("unroll") for (int k = 0; k < 2; ++k) \
        acc[ai][bj][m][n] = __builtin_amdgcn_mfma_f32_16x16x32_bf16(Bt[n][k], At[m][k], acc[ai][bj][m][n], 0, 0, 0); __builtin_amdgcn_s_setprio(0); } while (0)
#define PG8_WAIT_V(n) asm volatile("s_waitcnt vmcnt(" #n ")" ::: "memory")
#define PG8_WAIT_L(n) asm volatile("s_waitcnt lgkmcnt(" #n ")" ::: "memory")
#define PG8_BAR __builtin_amdgcn_s_barrier()
#define PG8_SCHED __builtin_amdgcn_sched_barrier(0)
    Unit cur, nxt; int ui = 0;
    if (!S.next(0, cur)) return;
    f32x4 acc[2][2][4][2];
#pragma unroll
    for (int a = 0; a < 2; ++a)
#pragma unroll
        for (int b = 0; b < 2; ++b)
#pragma unroll
            for (int m = 0; m < 4; ++m)
#pragma unroll
                for (int n = 0; n < 2; ++n) acc[a][b][m][n] = (f32x4){0.f, 0.f, 0.f, 0.f};
    bf16x8 At[4][2], B0[2][2], B1[2][2];
    const char* cA = (const char*)g.A + (size_t)cur.pm * tstep; const char* cB = (const char*)g.Bt + (size_t)cur.pn * tstep;
    S.a_ready(cur);
    if constexpr (SP2) {
        PG8_STAGE(PG8_SB(0, 0), cB, voffB); PG8_STAGE(PG8_SB(0, 1), cB + hstep, voffB); PG8_STAGE(PG8_SA(0, 0), cA, voffA); PG8_STAGE(PG8_SA(0, 1), cA + hstep, voffA);
        if (wr == 1) PG8_BAR;
        PG8_WAIT_V(2); PG8_BAR;
        PG8_STAGE(PG8_SB(1, 0), cB + kstep, voffB); PG8_STAGE(PG8_SA(1, 0), cA + kstep, voffA); PG8_STAGE(PG8_SB(1, 1), cB + hstep + kstep, voffB);
        PG8_WAIT_V(6); PG8_BAR;
    } else {
        PG8_STAGE(PG8_SB(0, 0), cB, voffB); PG8_STAGE(PG8_SA(0, 0), cA, voffA); PG8_STAGE(PG8_SB(0, 1), cB + hstep, voffB); PG8_STAGE(PG8_SA(0, 1), cA + hstep, voffA);
        if (wr == 1) PG8_BAR;
        PG8_WAIT_V(4); PG8_BAR;
        PG8_STAGE(PG8_SB(1, 0), cB + kstep, voffB); PG8_STAGE(PG8_SA(1, 0), cA + kstep, voffA); PG8_STAGE(PG8_SB(1, 1), cB + hstep + kstep, voffB);
        PG8_WAIT_V(6); PG8_BAR;
    }
    for (;;) {
        const bool has_next = S.next(ui + 1, nxt);
        const char* nA = has_next ? (const char*)g.A + (size_t)nxt.pm * tstep : cA; const char* nB = has_next ? (const char*)g.Bt + (size_t)nxt.pn * tstep : cB;
        for (int t = 0; t < nt; t += 2) {
            const bool last = (t == nt - 2);
            const char* a1 = cA + (size_t)(t + 1) * kstep;
            const char* a2 = last ? nA : cA + (size_t)(t + 2) * kstep; const char* b2 = last ? nB : cB + (size_t)(t + 2) * kstep;
            const char* a3 = a2 + kstep; const char* b3 = b2 + kstep;
            if (last && has_next) S.a_ready(nxt);
            if constexpr (SP2) {
            PG8_LDB(B0, 0, 0); PG8_LDB(B1, 0, 1); PG8_SCHED; PG8_LDA(At, 0, 0); PG8_STAGE(PG8_SA(1, 1), a1 + hstep, voffA);
            PG8_WAIT_V(8); PG8_WAIT_L(0); PG8_BAR; PG8_MMA(0, 0, At, B0); PG8_MMA(0, 1, At, B1); PG8_BAR; PG8_SCHED;
            PG8_LDA(At, 0, 1); PG8_STAGE(PG8_SB(0, 0), b2, voffB); PG8_STAGE(PG8_SB(0, 1), b2 + hstep, voffB); PG8_STAGE(PG8_SA(0, 0), a2, voffA);
            PG8_WAIT_V(8); PG8_WAIT_L(0); PG8_BAR; PG8_MMA(1, 0, At, B0); PG8_MMA(1, 1, At, B1); PG8_BAR; PG8_SCHED;
            PG8_LDB(B0, 1, 0); PG8_LDB(B1, 1, 1); PG8_SCHED; PG8_LDA(At, 1, 0); PG8_STAGE(PG8_SA(0, 1), a2 + hstep, voffA);
            PG8_WAIT_V(8); PG8_WAIT_L(0); PG8_BAR; PG8_MMA(0, 0, At, B0); PG8_MMA(0, 1, At, B1); PG8_BAR; PG8_SCHED;
            PG8_LDA(At, 1, 1); PG8_STAGE(PG8_SB(1, 0), b3, voffB); PG8_STAGE(PG8_SB(1, 1), b3 + hstep, voffB); PG8_STAGE(PG8_SA(1, 0), a3, voffA);
            PG8_WAIT_V(8); PG8_WAIT_L(0); PG8_BAR; PG8_MMA(1, 0, At, B0); PG8_MMA(1, 1, At, B1); PG8_BAR; PG8_SCHED;
            } else {
            PG8_LDB(B0, 0, 0); PG8_SCHED; PG8_LDA(At, 0, 0); PG8_STAGE(PG8_SA(1, 1), a1 + hstep, voffA);
            PG8_WAIT_L(8); PG8_BAR; PG8_WAIT_L(0); PG8_MMA(0, 0, At, B0); PG8_BAR; PG8_SCHED;
            PG8_LDB(B1, 0, 1); PG8_STAGE(PG8_SB(0, 0), b2, voffB);
            PG8_BAR; PG8_WAIT_L(0); PG8_MMA(0, 1, At, B1); PG8_BAR;
            PG8_LDA(At, 0, 1); PG8_STAGE(PG8_SA(0, 0), a2, voffA);
            PG8_BAR; PG8_WAIT_L(0); PG8_MMA(1, 0, At, B0); PG8_BAR; PG8_SCHED;
            PG8_STAGE(PG8_SB(0, 1), b2 + hstep, voffB);
            PG8_WAIT_V(6); PG8_BAR; PG8_MMA(1, 1, At, B1); PG8_BAR;
            PG8_LDB(B0, 1, 0); PG8_SCHED; PG8_LDA(At, 1, 0); PG8_STAGE(PG8_SA(0, 1), a2 + hstep, voffA);
            PG8_WAIT_L(8); PG8_BAR; PG8_WAIT_L(0); PG8_MMA(0, 0, At, B0); PG8_BAR; PG8_SCHED;
            PG8_LDB(B1, 1, 1); PG8_STAGE(PG8_SB(1, 0), b3, voffB);
            PG8_BAR; PG8_WAIT_L(0); PG8_MMA(0, 1, At, B1); PG8_BAR;
            PG8_LDA(At, 1, 1); PG8_STAGE(PG8_SA(1, 0), a3, voffA);
            PG8_BAR; PG8_WAIT_L(0); PG8_MMA(1, 0, At, B0); PG8_BAR; PG8_SCHED;
            PG8_STAGE(PG8_SB(1, 1), b3 + hstep, voffB);
            PG8_WAIT_V(6); PG8_BAR; PG8_MMA(1, 1, At, B1); PG8_BAR;
            }
        }
        if constexpr (ALIGN_EPI) { if (wr == 0) PG8_BAR; }
        if constexpr (!Epi::AFTER_DRAIN) { E(acc, cur, wr, wc, fr, fq); S.done(cur); }
        if (!has_next) break;
#pragma unroll
        for (int a = 0; a < 2; ++a)
#pragma unroll
            for (int b = 0; b < 2; ++b)
#pragma unroll
                for (int m = 0; m < 4; ++m)
#pragma unroll
                    for (int n = 0; n < 2; ++n) acc[a][b][m][n] = (f32x4){0.f, 0.f, 0.f, 0.f};
        cur = nxt; cA = nA; cB = nB; ++ui;
        if constexpr (ALIGN_EPI) { if (wr == 1) PG8_BAR; }
    }
    PG8_WAIT_V(0);
    if constexpr (!ALIGN_EPI) { if (wr == 0) PG8_BAR; }
    PG8_BAR;
    if constexpr (Epi::AFTER_DRAIN) { E.fused(acc, cur, wr, wc, fr, fq, lds, wid, lane); S.done(cur); }
#undef PG8_SA
#undef PG8_SB
#undef PG8_STAGE
#undef PG8_LDA
#undef PG8_LDB
#undef PG8_MMA
#undef PG8_WAIT_V
#undef PG8_WAIT_L
#undef PG8_BAR
#undef PG8_SCHED
}
}

namespace att {
using bf16 = unsigned short;
constexpr int D = 128, NW = 8, QBLK = 32, KVBLK = 64;
constexpr float SCALE = 0.088388347648318440f;
constexpr float THR = 8.f;
constexpr int SHM_V = KVBLK * D * 2, SHM_K = KVBLK * D * 2;
constexpr int LDS_WS = 2 * SHM_V + 2 * SHM_K, LDS_RPB = LDS_WS + NW * 64 * 4, LDS_TOTAL = LDS_RPB + 2048;
using bf16x8 = __attribute__((ext_vector_type(8))) short;
using s16x4  = __attribute__((ext_vector_type(4))) short;
using f32x16 = __attribute__((ext_vector_type(16))) float;
using f32x8  = __attribute__((ext_vector_type(8))) float;
using u32x4  = __attribute__((ext_vector_type(4))) unsigned;
#define KSWZ(row, colB) ((row) * 256 + ((colB) ^ (((row) & 7) << 4)))
#define SBAR() __builtin_amdgcn_sched_barrier(0)
__device__ __forceinline__ int crow(int r, int hi) { return (r & 3) + 8 * (r >> 2) + 4 * hi; }
__device__ __forceinline__ unsigned cvtpk(float lo, float hi) {
  unsigned r; asm volatile("v_cvt_pk_bf16_f32 %0, %1, %2" : "=v"(r) : "v"(lo), "v"(hi)); return r;
}
template <typename TIn> struct Stage;
template <> struct Stage<bf16>  { using T = bf16x8;
  __device__ static __forceinline__ T ld8(const bf16* p) { return *reinterpret_cast<const bf16x8*>(p); }
  __device__ static __forceinline__ bf16x8 tobf(T x) { return x; } };
template <> struct Stage<float> { using T = f32x8;
  __device__ static __forceinline__ T ld8(const float* p) { return *reinterpret_cast<const f32x8*>(p); }
  __device__ static __forceinline__ bf16x8 tobf(T x) {
    u32x4 w = {cvtpk(x[0], x[1]), cvtpk(x[2], x[3]), cvtpk(x[4], x[5]), cvtpk(x[6], x[7])}; return *reinterpret_cast<bf16x8*>(&w); } };

__device__ __forceinline__ void partialSM(f32x16& p0, f32x16& p1, float& m_reg, float& mn, float& alpha) {
  constexpr float C = SCALE * 1.4426950408889634f;
  float pmax = p0[0]; for (int r = 1; r < 16; ++r) pmax = fmaxf(pmax, p0[r]); for (int r = 0; r < 16; ++r) pmax = fmaxf(pmax, p1[r]);
  { auto rr = __builtin_amdgcn_permlane32_swap(__float_as_uint(pmax), __float_as_uint(pmax), false, false);
    pmax = fmaxf(__uint_as_float(rr[0]), __uint_as_float(rr[1])); }
  if (__builtin_expect(__all(pmax - m_reg <= THR / SCALE), 1)) { mn = m_reg; alpha = 1.f; }
  else { mn = fmaxf(m_reg, pmax); alpha = __builtin_amdgcn_exp2f((m_reg - mn) * C); m_reg = mn; }
  float mnC = -mn * C;
  for (int r = 0; r < 16; ++r) p0[r] = fmaf(p0[r], C, mnC); for (int r = 0; r < 16; ++r) p1[r] = fmaf(p1[r], C, mnC);
  for (int r = 0; r < 16; ++r) p0[r] = __builtin_amdgcn_exp2f(p0[r]);
}
__device__ __forceinline__ void finishSM(f32x16& p0, f32x16& p1, float alpha, float& l_reg, bf16x8& pa0, bf16x8& pa1, bf16x8& pa2, bf16x8& pa3) {
  for (int r = 0; r < 16; ++r) p1[r] = __builtin_amdgcn_exp2f(p1[r]);
  float ps = 0; for (int r = 0; r < 16; ++r) ps += p0[r]; for (int r = 0; r < 16; ++r) ps += p1[r];
  { auto rr = __builtin_amdgcn_permlane32_swap(__float_as_uint(ps), __float_as_uint(ps), false, false);
    ps = __uint_as_float(rr[0]) + __uint_as_float(rr[1]); }
  l_reg = l_reg * alpha + ps;
#define PK4(P, BASE, OUT) do { unsigned a0 = cvtpk(P[BASE + 0], P[BASE + 1]), a1 = cvtpk(P[BASE + 2], P[BASE + 3]);   \
    unsigned b0 = cvtpk(P[BASE + 4], P[BASE + 5]), b1 = cvtpk(P[BASE + 6], P[BASE + 7]);                              \
    auto r0 = __builtin_amdgcn_permlane32_swap(a0, b0, false, false); auto r1 = __builtin_amdgcn_permlane32_swap(a1, b1, false, false); \
    u32x4 w = {r0[0], r1[0], r0[1], r1[1]}; OUT = *reinterpret_cast<bf16x8*>(&w); } while (0)
  PK4(p0, 0, pa0); PK4(p0, 8, pa1); PK4(p1, 0, pa2); PK4(p1, 8, pa3);
#undef PK4
}
__device__ __forceinline__ void qkt(f32x16& p0, f32x16& p1, const bf16* Ks, const bf16x8* qr, int r32, int hi) {
  p0 = f32x16{}; p1 = f32x16{};
  for (int d0 = 0; d0 < 8; ++d0) { int cb = (d0 * 16 + hi * 8) * 2;
    bf16x8 b0 = *reinterpret_cast<const bf16x8*>((const char*)Ks + KSWZ(r32, cb));
    bf16x8 b1 = *reinterpret_cast<const bf16x8*>((const char*)Ks + KSWZ(32 + r32, cb));
    p0 = __builtin_amdgcn_mfma_f32_32x32x16_bf16(b0, qr[d0], p0, 0, 0, 0);
    p1 = __builtin_amdgcn_mfma_f32_32x32x16_bf16(b1, qr[d0], p1, 0, 0, 0); }
}
__device__ __forceinline__ int v_st(int k, int c) { const int kk = (k & ~0xC) | ((k & 4) << 1) | ((k & 8) >> 1); return ((kk >> 3) * 4 + (c >> 5)) * 512 + ((kk & 7) * 32 + (c & 31)) * 2; }
__device__ __forceinline__ int v_rd_base(int lane) { return ((lane & 3) << 3) | (((lane >> 2) & 3) << 6) | (((lane >> 4) & 1) << 5) | (((lane >> 5) & 1) << 8); }
constexpr int v_rd_off(int d0, int ks, int half) { return d0 * 512 + ks * 4096 + half * 2048; }
template <int OFF> __device__ __forceinline__ s16x4 tr_read(int vb) {
  s16x4 r; asm volatile("ds_read_b64_tr_b16 %0, %1 offset:%2" : "=&v"(r) : "v"(vb), "i"(OFF) : "memory"); return r;
}
template <int D0> __device__ __forceinline__ void pv_one(f32x16& od, int vb, bf16x8 pa0, bf16x8 pa1, bf16x8 pa2, bf16x8 pa3) {
  const s16x4 l0 = tr_read<v_rd_off(D0, 0, 0)>(vb), h0 = tr_read<v_rd_off(D0, 0, 1)>(vb), l1 = tr_read<v_rd_off(D0, 1, 0)>(vb), h1 = tr_read<v_rd_off(D0, 1, 1)>(vb);
  const s16x4 l2 = tr_read<v_rd_off(D0, 2, 0)>(vb), h2 = tr_read<v_rd_off(D0, 2, 1)>(vb), l3 = tr_read<v_rd_off(D0, 3, 0)>(vb), h3 = tr_read<v_rd_off(D0, 3, 1)>(vb);
  asm volatile("s_waitcnt lgkmcnt(0)" ::: "memory"); SBAR();
#define PK(L, H) (bf16x8){L[0], L[1], L[2], L[3], H[0], H[1], H[2], H[3]}
  od = __builtin_amdgcn_mfma_f32_32x32x16_bf16(pa0, PK(l0, h0), od, 0, 0, 0);
  od = __builtin_amdgcn_mfma_f32_32x32x16_bf16(pa1, PK(l1, h1), od, 0, 0, 0);
  od = __builtin_amdgcn_mfma_f32_32x32x16_bf16(pa2, PK(l2, h2), od, 0, 0, 0);
  od = __builtin_amdgcn_mfma_f32_32x32x16_bf16(pa3, PK(l3, h3), od, 0, 0, 0);
#undef PK
}
__device__ __forceinline__ void pv_d0(f32x16* o, int vb, bf16x8 pa0, bf16x8 pa1, bf16x8 pa2, bf16x8 pa3) {
  pv_one<0>(o[0], vb, pa0, pa1, pa2, pa3); pv_one<1>(o[1], vb, pa0, pa1, pa2, pa3); pv_one<2>(o[2], vb, pa0, pa1, pa2, pa3); pv_one<3>(o[3], vb, pa0, pa1, pa2, pa3);
}
struct AUnit {
    const bf16* Q; const bf16* K; const bf16* V; bf16* O; const float* rpb;
    int ldq, ldk, ldo, ntiles, nband, band0, ctx0, qrow0;
};
__device__ __forceinline__ unsigned short f2bf1(float v) { return (unsigned short)(cvtpk(v, v) & 0xffffu); }

__device__ __forceinline__ void attn_unit(const AUnit& U, char* lds) {
  int tid = threadIdx.x; asm volatile("" : "+v"(tid));
  const int wid = __builtin_amdgcn_readfirstlane(tid >> 6), lane = tid & 63, r32 = lane & 31, hi = lane >> 5;
  bf16* V_lds = (bf16*)lds; bf16* K_lds = (bf16*)(lds + 2 * SHM_V);
  float* ws = (float*)(lds + LDS_WS) + wid * 64; float* li_l = ws; float* al_l = ws + 32;
  float* rpbL = (float*)(lds + LDS_RPB);
  const int nband = U.nband, nt = U.ntiles;
  if (nband > 0 && tid < 465) rpbL[tid] = U.rpb[tid] * (1.0f / SCALE);
  float m_reg = -1e30f, l_reg = 0.f; f32x16 o[4] = {}; bf16x8 qr[8];
  const bf16* Qw = U.Q + (long)(wid * QBLK + r32) * U.ldq + hi * 8;
#pragma unroll
  for (int d0 = 0; d0 < 8; ++d0) qr[d0] = *reinterpret_cast<const bf16x8*>(Qw + d0 * 16);
  const int sr = tid >> 4, sc = (tid & 15) * 8, vst0 = v_st(sr, sc), vst1 = v_st(32 + sr, sc);
  const int vb0 = (int)(uintptr_t)V_lds + v_rd_base(lane);
  const int gr = U.qrow0 + (wid >> 1), qc = (wid & 1) * 32 + r32;
  const int rstart = min(max(gr - 4, 0), 24), cs = min(max(qc - 8, 0), 48);
  bf16x8 vs0, vs1, ks0, ks1;
#define A_KBASE(j) (((j) < nband) ? (U.band0 + (j)) * KVBLK : U.ctx0 + ((j) - nband) * KVBLK)
#define A_SLOAD(k0) do { vs0 = *reinterpret_cast<const bf16x8*>(U.V + (long)((k0) + sr) * U.ldk + sc); vs1 = *reinterpret_cast<const bf16x8*>(U.V + (long)((k0) + 32 + sr) * U.ldk + sc); \
    ks0 = *reinterpret_cast<const bf16x8*>(U.K + (long)((k0) + sr) * U.ldk + sc); ks1 = *reinterpret_cast<const bf16x8*>(U.K + (long)((k0) + 32 + sr) * U.ldk + sc); } while (0)
#define A_SWRITE(b) do { *(bf16x8*)((char*)V_lds + (b) * SHM_V + vst0) = vs0; *(bf16x8*)((char*)V_lds + (b) * SHM_V + vst1) = vs1; const int kc_ = sc * 2; \
    *(bf16x8*)((char*)K_lds + (b) * SHM_K + KSWZ(sr, kc_)) = ks0; *(bf16x8*)((char*)K_lds + (b) * SHM_K + KSWZ(32 + sr, kc_)) = ks1; } while (0)
  { const int k0 = A_KBASE(0); A_SLOAD(k0); }
  A_SWRITE(0); __syncthreads();
  for (int j = 0; j < nt; ++j) {
    const int buf = j & 1;
    if (j + 1 < nt) { const int k1 = A_KBASE(j + 1); A_SLOAD(k1); }
    bool active = true; int dr = 0; const bool band = j < nband;
    if (band) { const int krow = U.band0 + j; active = (krow >= rstart) && (krow < rstart + 8); dr = krow - gr; }
    if (active) {
      f32x16 p0, p1; float mn, alpha; bf16x8 pa0, pa1, pa2, pa3;
      SBAR(); qkt(p0, p1, (const bf16*)((const char*)K_lds + buf * SHM_K), qr, r32, hi);
      if (band) {
        const float* brow = rpbL + (dr + 7) * 31 + 15;
#pragma unroll
        for (int r = 0; r < 16; ++r) {
          const int kc0 = crow(r, hi), kc1 = kc0 + 32;
          { const bool ok = (kc0 >= cs) && (kc0 < cs + 16); const int dc = min(max(kc0 - qc, -15), 15); const float b = brow[dc]; p0[r] = ok ? p0[r] + b : -1e30f; }
          { const bool ok = (kc1 >= cs) && (kc1 < cs + 16); const int dc = min(max(kc1 - qc, -15), 15); const float b = brow[dc]; p1[r] = ok ? p1[r] + b : -1e30f; }
        }
      }
      partialSM(p0, p1, m_reg, mn, alpha);
      if (__any(alpha < 1.f)) { if (hi == 0) al_l[r32] = alpha; asm volatile("s_waitcnt lgkmcnt(0)" ::: "memory");
#pragma unroll
        for (int d = 0; d < 4; ++d)
#pragma unroll
          for (int r = 0; r < 16; ++r) o[d][r] *= al_l[crow(r, hi)]; }
      finishSM(p0, p1, alpha, l_reg, pa0, pa1, pa2, pa3); SBAR();
      pv_d0(o, vb0 + buf * (int)SHM_V, pa0, pa1, pa2, pa3);
    }
    if (j + 1 < nt) A_SWRITE(buf ^ 1);
    __syncthreads();
  }
  if (hi == 0) li_l[r32] = l_reg; asm volatile("s_waitcnt lgkmcnt(0)" ::: "memory");
  float rli[16];
#pragma unroll
  for (int r = 0; r < 16; ++r) rli[r] = __builtin_amdgcn_rcpf(li_l[crow(r, hi)]);
  bf16* Ow = U.O + (long)(wid * QBLK) * U.ldo;
#pragma unroll
  for (int r = 0; r < 16; ++r) { const int orow = crow(r, hi);
#pragma unroll
    for (int d0 = 0; d0 < 4; ++d0) Ow[(long)orow * U.ldo + d0 * 32 + r32] = f2bf1(o[d0][r] * rli[r]); }
#undef A_KBASE
#undef A_SLOAD
#undef A_SWRITE
}
}

constexpr size_t MiB = 1u << 20;
constexpr size_t WS_CTL = 0, CTL_ZERO_BYTES = 1 * MiB;
constexpr size_t WS_MOD = 1 * MiB;
constexpr size_t WS_ROPE = 2 * MiB;
constexpr size_t WS_POOLW = 3 * MiB;
constexpr size_t WS_WINAB = 4 * MiB;
constexpr size_t WS_WOUTAB = WS_WINAB + (size_t)2 * 3072 * 2048 * 2;
constexpr size_t WS_WINCD = WS_WOUTAB + (size_t)2 * 2048 * 2048 * 2;
constexpr size_t WS_WOUTCD = WS_WINCD + (size_t)2 * 6144 * 2048 * 2;
constexpr size_t WS_WGU = WS_WOUTCD + (size_t)2 * 2048 * 2048 * 2;
constexpr size_t WS_WDN = WS_WGU + (size_t)4 * NGU * 2048 * 2;
constexpr size_t WS_H = WS_WDN + (size_t)4 * 2048 * FFH * 2;
constexpr size_t WS_PROJ = WS_H + (size_t)MTOK * DM * 2;
constexpr size_t WS_MIX = WS_PROJ + (size_t)MTOK * CD_IN * 2;
constexpr size_t WS_Y = WS_MIX + (size_t)MTOK * DM * 2;
constexpr size_t WS_X = WS_Y + (size_t)MTOK * DM * 4;
constexpr size_t WS_KLAB = WS_X + (size_t)MTOK * DM * 4;
constexpr size_t WS_VLAB = WS_KLAB + (size_t)2 * 2 * LKV * 512 * 2;
constexpr size_t WS_KLCD = WS_VLAB + (size_t)2 * 2 * LKV * 512 * 2;
constexpr size_t WS_VLCD = WS_KLCD + (size_t)2 * 2 * LKV * 1536 * 2;
constexpr size_t WS_END = WS_VLCD + (size_t)2 * 2 * LKV * 1536 * 2;
static_assert(WS_WINAB % 256 == 0 && WS_H % 256 == 0 && WS_KLAB % 256 == 0 && WS_END % 256 == 0, "alignment");
constexpr int CW_BAR = 4096;
constexpr int CW_Q = 16384;
constexpr size_t O_Y = 0;
__host__ __device__ constexpr size_t out_k_off(int i) { return i == 0 ? 25165824u : i == 1 ? 33554432u : i == 2 ? 58720256u : 67108864u; }
__host__ __device__ constexpr size_t out_v_off(int i) { return i == 0 ? 29360128u : i == 1 ? 46137344u : i == 2 ? 62914560u : 79691776u; }
constexpr size_t OUT_TOTAL = 92274688u;

constexpr int RING_OFF = 0, RING_BYTES = 131072;
constexpr int LDSCTL_OFF = RING_BYTES, MISC_OFF = LDSCTL_OFF + 320;
constexpr int LDS_BYTES = 147456;
static_assert(att::LDS_TOTAL <= RING_BYTES, "attention LDS fits the ring region");
constexpr int NWAVES = 8, NPHASES = 34;

#define GAS __attribute__((address_space(1)))
#define LAS __attribute__((address_space(3)))
typedef unsigned short bf16;
typedef unsigned v4u __attribute__((ext_vector_type(4)));
typedef float f32x4 __attribute__((ext_vector_type(4)));
typedef short bf16x8 __attribute__((ext_vector_type(8)));
typedef GAS unsigned gu32;
typedef GAS unsigned long long gu64;
#define RLX_AGENT __ATOMIC_RELAXED, __HIP_MEMORY_SCOPE_AGENT
#define LDS_WAIT() asm volatile("s_waitcnt lgkmcnt(0)" ::: "memory")
#define VM_WAIT() asm volatile("s_waitcnt vmcnt(0)" ::: "memory")
__device__ __forceinline__ unsigned long long rt() { return __builtin_amdgcn_s_memrealtime(); }
__device__ __forceinline__ unsigned f2bf(float f) { unsigned u = __builtin_bit_cast(unsigned, f); return (u + 0x7fffu + ((u >> 16) & 1u)) >> 16; }
__device__ __forceinline__ unsigned pk2(float lo, float hi) { return f2bf(lo) | (f2bf(hi) << 16); }

#define XB_TMO      128
#define XB_XCNT(j)  (256  + 64 * (j))
#define XB_XSUB(j)  (1280 + 64 * (j))
#define XB_XGEN(j)  (2304 + 64 * (j))
#define XB_TOP      3328
#define XB_TOPGEN   3392
#define XCD_BAR_WORDS 3456
#define XB_SPIN_CAP (1u << 18)

__device__ __forceinline__ unsigned xb_ld(unsigned* p)              { return __hip_atomic_load(p, __ATOMIC_RELAXED, __HIP_MEMORY_SCOPE_AGENT); }
__device__ __forceinline__ unsigned xb_add(unsigned* p, unsigned v) { return __hip_atomic_fetch_add(p, v, __ATOMIC_RELAXED, __HIP_MEMORY_SCOPE_AGENT); }
__device__ __forceinline__ unsigned xb_xcc_id() { return (unsigned)__builtin_amdgcn_s_getreg((3 << 11) | 20) & 0xFu; }
#define XB_SPIN(cond, bar) do { unsigned _sp = 0; while (cond) { __builtin_amdgcn_s_sleep(1); \
    if ((++_sp & 255u) == 0u) { if (xb_ld(&(bar)[XB_TMO])) break; if (_sp > XB_SPIN_CAP) { atomicAdd(&(bar)[XB_TMO], 1u); break; } } } } while (0)

struct XcdBarrier {
    unsigned* bar; unsigned x;
    volatile LAS unsigned* st;
};

__device__ __forceinline__ XcdBarrier xcd_barrier_post(unsigned* bar, volatile LAS unsigned* st) {
    XcdBarrier b; b.bar = bar; b.x = xb_xcc_id(); b.st = st;
    if (threadIdx.x == 0) (void)xb_add(&bar[XB_XCNT(b.x)], 1u);
    return b;
}
__device__ __forceinline__ void xcd_barrier_complete(unsigned* bar, unsigned x, unsigned& nloc, unsigned& nx) {
    const unsigned G = gridDim.x * gridDim.y * gridDim.z;
    unsigned sum, cnt, mine, sp = 0u;
    for (;;) {
        sum = 0u; cnt = 0u; mine = 0u;
#pragma unroll
        for (unsigned j = 0; j < 16; ++j) { const unsigned c = xb_ld(&bar[XB_XCNT(j)]); sum += c; cnt += (c > 0u) ? 1u : 0u; mine = (j == x) ? c : mine; }
        if (sum == G) break;
        __builtin_amdgcn_s_sleep(1);
        if ((++sp & 255u) == 0u) { if (xb_ld(&bar[XB_TMO])) break; if (sp > XB_SPIN_CAP) { atomicAdd(&bar[XB_TMO], 1u); break; } }
    }
    nloc = mine > 0u ? mine : 1u; nx = cnt > 0u ? cnt : 1u;
}

__device__ __forceinline__ void xcd_barrier(const XcdBarrier& b) {
    asm volatile("s_waitcnt vmcnt(0)" ::: "memory");
    __syncthreads();
    if (threadIdx.x == 0) {
        unsigned* bar = b.bar;
        __builtin_amdgcn_s_waitcnt(0);
        unsigned nloc = b.st[0], nx = b.st[1];
        if (nloc == 0u) { xcd_barrier_complete(bar, b.x, nloc, nx); b.st[0] = nloc; b.st[1] = nx; }
        const unsigned old = xb_add(&bar[XB_XSUB(b.x)], 1u);
        const unsigned gen = old / nloc;
        if (old + 1u == (gen + 1u) * nloc) {
            __builtin_amdgcn_fence(__ATOMIC_RELEASE, "agent");
            asm volatile("s_waitcnt vmcnt(0)" ::: "memory");
            const unsigned og = xb_add(&bar[XB_TOP], 1u);
            const unsigned tg = og / nx;
            if (og + 1u == (tg + 1u) * nx) xb_add(&bar[XB_TOPGEN], 1u);
            else XB_SPIN(xb_ld(&bar[XB_TOPGEN]) == tg, bar);
            __builtin_amdgcn_fence(__ATOMIC_ACQUIRE, "agent");
            xb_add(&bar[XB_XGEN(b.x)], 1u);
            asm volatile("s_waitcnt vmcnt(0)" ::: "memory");
        } else {
            XB_SPIN(xb_ld(&bar[XB_XGEN(b.x)]) == gen, bar);
            __builtin_amdgcn_fence(__ATOMIC_ACQUIRE, "agent");
            asm volatile("s_waitcnt vmcnt(0)" ::: "memory");
        }
    }
    __syncthreads();
}

struct Args { const float* in[31]; float* out; unsigned char* ws; int ph_lo, ph_hi; };
struct Frame {
    LAS unsigned char* lds; char* ldsg;
    volatile LAS unsigned* MISC;
    gu32* ctl;
    int vcu, G;
};
__device__ __forceinline__ int otid() { int t = threadIdx.x; asm volatile("" : "+v"(t)); return t; }
#define LANE_VARS const int tid_ = otid(), lane_ = tid_ & 63, wave_ = __builtin_amdgcn_readfirstlane(tid_ >> 6)

__device__ __forceinline__ float wave_sum(float v) {
#pragma unroll
    for (int o = 1; o < 64; o <<= 1) v += __shfl_xor(v, o);
    return v;
}
__device__ __forceinline__ float bf2f(unsigned short b) { return __builtin_bit_cast(float, (unsigned)b << 16); }
__device__ __forceinline__ float bflo(unsigned w) { return __builtin_bit_cast(float, w << 16); }
__device__ __forceinline__ float bfhi(unsigned w) { return __builtin_bit_cast(float, w & 0xffff0000u); }
__device__ __forceinline__ unsigned pkbf(float lo, float hi) { return pg8::cvt_pk_bf16(lo, hi); }
typedef unsigned u32x2v __attribute__((ext_vector_type(2)));
typedef float f32x16 __attribute__((ext_vector_type(16)));
__device__ __forceinline__ void unpack8(const v4u& w, float (&x)[8]) { x[0] = bflo(w.x); x[1] = bfhi(w.x); x[2] = bflo(w.y); x[3] = bfhi(w.y); x[4] = bflo(w.z); x[5] = bfhi(w.z); x[6] = bflo(w.w); x[7] = bfhi(w.w); }
__device__ __forceinline__ v4u pack8(const float (&x)[8]) { v4u w; w.x = pkbf(x[0], x[1]); w.y = pkbf(x[2], x[3]); w.z = pkbf(x[4], x[5]); w.w = pkbf(x[6], x[7]); return w; }

__device__ __forceinline__ void transpose_item(const float* W, int K, int N, bf16* WT, int mode, LAS float* scr, int item, int lane) {
    const int nblk = N / 32, kb = item / nblk, nb = item % nblk, k0 = 64 * kb, n0 = 32 * nb;
    int rb = n0; if (mode) rb = (n0 >> 7) * 256 + (n0 & 127) + (mode == 2 ? 128 : 0);
#pragma unroll 8
    for (int i = 0; i < 32; ++i) { const int kk = 2 * i + (lane >> 5); scr[kk * 33 + (lane & 31)] = W[(size_t)(k0 + kk) * N + n0 + (lane & 31)]; }
    LDS_WAIT(); asm volatile("" ::: "memory");
    const int c = lane & 7;
#pragma unroll
    for (int j = 0; j < 4; ++j) { const int n = (lane >> 3) + 8 * j; const LAS float* s = scr + (8 * c) * 33 + n;
        v4u o; o.x = pkbf(s[0 * 33], s[1 * 33]); o.y = pkbf(s[2 * 33], s[3 * 33]); o.z = pkbf(s[4 * 33], s[5 * 33]); o.w = pkbf(s[6 * 33], s[7 * 33]);
        *(GAS v4u*)(WT + (size_t)(rb + n) * K + k0 + 8 * c) = o; }
    LDS_WAIT(); asm volatile("" ::: "memory");
}

__device__ __forceinline__ void p0_prologue(Frame& F, const Args& A) {
    LANE_VARS;
    unsigned char* ws = A.ws;
    float* MOD = (float*)(ws + WS_MOD);
    {
        LAS float* S = (LAS float*)(F.lds);
        LAS f32x4* red = (LAS f32x4*)(F.lds + 24576);
        const float* c_lat = A.in[10]; const float* c_ctx = A.in[11]; const float* w_ada = A.in[12]; const float* b_ada = A.in[13];
        bool filled = false;
        for (int it = F.vcu; it < 192; it += F.G) {
            if (!filled) {
                for (int e = tid_; e < 3 * 2048; e += NWAVES * 64) { const int c = e >> 11, k = e & 2047; const float v = (c == 0) ? c_ctx[k] : c_lat[(c - 1) * 2048 + k];
                    S[e] = v / (1.0f + __expf(-v)); }
                filled = true;
            }
            __syncthreads();
            const int layer = it / 48, n = (it % 48) * 256 + 4 * lane_;
            const float* wp = w_ada + ((size_t)layer * 2048 + 256 * wave_) * 12288 + n;
            f32x4 a0 = {0.f, 0.f, 0.f, 0.f}, a1 = a0, a2 = a0;
#pragma unroll 8
            for (int k = 0; k < 256; ++k) { const f32x4 w4 = *(const f32x4*)(wp + (size_t)k * 12288); const int kk = 256 * wave_ + k;
                a0 += w4 * S[kk]; a1 += w4 * S[2048 + kk]; a2 += w4 * S[4096 + kk]; }
            red[(wave_ * 3 + 0) * 64 + lane_] = a0; red[(wave_ * 3 + 1) * 64 + lane_] = a1; red[(wave_ * 3 + 2) * 64 + lane_] = a2;
            __syncthreads();
            if (tid_ < 192) { const int c = tid_ >> 6, l = tid_ & 63; f32x4 s = red[(0 * 3 + c) * 64 + l];
#pragma unroll
                for (int w = 1; w < 8; ++w) s += red[(w * 3 + c) * 64 + l];
                const int nn = (it % 48) * 256 + 4 * l; s += *(const f32x4*)(b_ada + (size_t)layer * 12288 + nn);
                *(f32x4*)(MOD + ((size_t)layer * 3 + c) * 12288 + nn) = s; }
        }
        __syncthreads();
    }
    {
        LAS float* scr = (LAS float*)(F.lds + wave_ * 8448);
        constexpr int I_INAB = 32 * 96, I_OUT = 32 * 64, I_INCD = 32 * 192, I_GU = 32 * 176, I_DN = 88 * 64;
        constexpr int NIT = 2 * I_INAB + 2 * I_OUT + 2 * I_INCD + 2 * I_OUT + 4 * I_GU + 4 * I_GU + 4 * I_DN;
        static_assert(NIT == 94208, "transpose items");
        int start, cnt;
        if (F.G == 256) { if (F.vcu < 192) { start = F.vcu * 334; cnt = 334; } else { start = 192 * 334 + (F.vcu - 192) * 470; cnt = 470; } }
        else { const int per = (NIT + F.G - 1) / F.G; start = F.vcu * per; cnt = per; }
        int end = start + cnt; if (end > NIT) end = NIT;
        for (int it = start + wave_; it < end; it += NWAVES) {
            int r = it;
            if (r < 2 * I_INAB) { const int j = r / I_INAB; transpose_item(A.in[18] + (size_t)j * 2048 * 3072, 2048, 3072, (bf16*)(ws + WS_WINAB) + (size_t)j * 3072 * 2048, 0, scr, r % I_INAB, lane_); continue; } r -= 2 * I_INAB;
            if (r < 2 * I_OUT) { const int j = r / I_OUT; transpose_item(A.in[19] + (size_t)j * 2048 * 2048, 2048, 2048, (bf16*)(ws + WS_WOUTAB) + (size_t)j * 2048 * 2048, 0, scr, r % I_OUT, lane_); continue; } r -= 2 * I_OUT;
            if (r < 2 * I_INCD) { const int j = r / I_INCD; transpose_item(A.in[24] + (size_t)j * 2048 * 6144, 2048, 6144, (bf16*)(ws + WS_WINCD) + (size_t)j * 6144 * 2048, 0, scr, r % I_INCD, lane_); continue; } r -= 2 * I_INCD;
            if (r < 2 * I_OUT) { const int j = r / I_OUT; transpose_item(A.in[25] + (size_t)j * 2048 * 2048, 2048, 2048, (bf16*)(ws + WS_WOUTCD) + (size_t)j * 2048 * 2048, 0, scr, r % I_OUT, lane_); continue; } r -= 2 * I_OUT;
            if (r < 4 * I_GU) { const int j = r / I_GU; transpose_item(A.in[28] + (size_t)j * 2048 * FFH, 2048, FFH, (bf16*)(ws + WS_WGU) + (size_t)j * NGU * 2048, 1, scr, r % I_GU, lane_); continue; } r -= 4 * I_GU;
            if (r < 4 * I_GU) { const int j = r / I_GU; transpose_item(A.in[29] + (size_t)j * 2048 * FFH, 2048, FFH, (bf16*)(ws + WS_WGU) + (size_t)j * NGU * 2048, 2, scr, r % I_GU, lane_); continue; } r -= 4 * I_GU;
            { const int j = r / I_DN; transpose_item(A.in[30] + (size_t)j * FFH * 2048, FFH, 2048, (bf16*)(ws + WS_WDN) + (size_t)j * 2048 * FFH, 0, scr, r % I_DN, lane_); }
        }
    }
    const int gt = F.vcu * (NWAVES * 64) + tid_, NT = F.G * NWAVES * 64;
    {
        constexpr int C_AB = 2 * 256 * 512 / 8, C_CD = 2 * 256 * 1536 / 8;
        for (int idx = gt; idx < 4 * C_AB + 4 * C_CD; idx += NT) {
            const float* src; bf16* dst; int W, e;
            if (idx < 4 * C_AB) { const int tsr = idx / C_AB; e = (idx % C_AB) * 8; const int j = tsr >> 1, isv = tsr & 1; W = 512;
                src = A.in[2 + 4 * j + isv]; dst = (bf16*)(ws + (isv ? WS_VLAB : WS_KLAB)) + (size_t)j * 2 * LKV * 512; }
            else { const int q = idx - 4 * C_AB; const int tsr = q / C_CD; e = (q % C_CD) * 8; const int j = tsr >> 1, isv = tsr & 1; W = 1536;
                src = A.in[4 + 4 * j + isv]; dst = (bf16*)(ws + (isv ? WS_VLCD : WS_KLCD)) + (size_t)j * 2 * LKV * 1536; }
            const int b = e / (256 * W), rem = e % (256 * W), p = rem / W, c = rem % W;
            const f32x4 x0 = *(const f32x4*)(src + e), x1 = *(const f32x4*)(src + e + 4);
            v4u o; o.x = pkbf(x0[0], x0[1]); o.y = pkbf(x0[2], x0[3]); o.z = pkbf(x1[0], x1[1]); o.w = pkbf(x1[2], x1[3]);
            *(v4u*)(dst + ((size_t)(b * LKV + LSEQ + p)) * W + c) = o;
        }
    }
    {
        float* ROPE = (float*)(ws + WS_ROPE);
        for (int idx = gt; idx < 2048 * 64; idx += NT) { const int t = idx >> 6, i = idx & 63, fi = i & 31; const int pos = (i < 32) ? (t >> 6) : (t & 63);
            double inv = 1.0; for (int q = 0; q < fi; ++q) inv *= 0.74989420933245582;
            const double rev = (double)pos * inv * 0.15915494309189535; const float fr = (float)(rev - __builtin_rint(rev));
            ROPE[2 * idx] = __builtin_amdgcn_cosf(fr); ROPE[2 * idx + 1] = __builtin_amdgcn_sinf(fr); }
    }
    {
        bf16* PW = (bf16*)(ws + WS_POOLW); const float* pw = A.in[20];
        for (int idx = gt; idx < 2 * 4 * 128 * 128; idx += NT) { const int k = idx & 127, n = (idx >> 7) & 127, jg = idx >> 14;
            PW[idx] = (bf16)(pkbf(pw[((size_t)jg * 128 + k) * 128 + n], 0.f) & 0xffffu); }
    }
}

__device__ __forceinline__ void p1_modulate_x(Frame& F, const Args& A) {
    LANE_VARS;
    const int gw = F.vcu * NWAVES + wave_, NGW = F.G * NWAVES;
    const float* MOD = (const float*)(A.ws + WS_MOD); bf16* H = (bf16*)(A.ws + WS_H);
    for (int row = gw; row < MTOK; row += NGW) {
        const float* src = (row < NCTX) ? A.in[0] + (size_t)row * DM : A.in[1] + (size_t)(row - NCTX) * DM;
        const int cond = (row < NCTX) ? 0 : 1 + ((row - NCTX) >> 11);
        const f32x4* x4 = (const f32x4*)src + lane_; const f32x4* sh = (const f32x4*)(MOD + (size_t)cond * 12288) + lane_; const f32x4* sc = (const f32x4*)(MOD + (size_t)cond * 12288 + 2048) + lane_;
        u32x2v* o = (u32x2v*)(H + (size_t)row * DM) + lane_;
#pragma unroll
        for (int j = 0; j < 8; ++j) { const f32x4 v = x4[64 * j], s = sc[64 * j], h = sh[64 * j]; const f32x4 r = v * (s + 1.0f) + h;
            u32x2v w; w.x = pkbf(r[0], r[1]); w.y = pkbf(r[2], r[3]); o[64 * j] = w; }
    }
}

__device__ __forceinline__ void ln_phase(Frame& F, const float* Y, float* Xo, const float* lg, const float* lb, const float* mod_sh  , bf16* H) {
    LANE_VARS;
    const int gw = F.vcu * NWAVES + wave_, NGW = F.G * NWAVES;
    for (int row = gw; row < MTOK; row += NGW) {
        const f32x4* y4 = (const f32x4*)(Y + (size_t)row * DM) + lane_;
        f32x4 v[8]; float s = 0.f;
#pragma unroll
        for (int j = 0; j < 8; ++j) { v[j] = y4[64 * j]; s += (v[j][0] + v[j][1]) + (v[j][2] + v[j][3]); }
        const float mean = wave_sum(s) * (1.0f / DM); float q = 0.f;
#pragma unroll
        for (int j = 0; j < 8; ++j) { v[j] = v[j] - mean; q += (v[j][0] * v[j][0] + v[j][1] * v[j][1]) + (v[j][2] * v[j][2] + v[j][3] * v[j][3]); }
        const float rstd = 1.0f / sqrtf(wave_sum(q) * (1.0f / DM) + LN_EPS);
        const int cond = (row < NCTX) ? 0 : 1 + ((row - NCTX) >> 11);
        f32x4* xo = (f32x4*)(Xo + (size_t)row * DM) + lane_; const f32x4* g4 = (const f32x4*)lg + lane_; const f32x4* b4 = (const f32x4*)lb + lane_;
        const float* msh = mod_sh ? mod_sh : lg;
        const f32x4* sh = (const f32x4*)(msh + (size_t)cond * 12288) + lane_; const f32x4* sc = (const f32x4*)(msh + (size_t)cond * 12288 + 2048) + lane_;
        u32x2v* o = (u32x2v*)(H + (size_t)row * DM) + lane_;
#pragma unroll
        for (int j = 0; j < 8; ++j) { const f32x4 x = v[j] * rstd * g4[64 * j] + b4[64 * j]; xo[64 * j] = x;
            if (mod_sh) { const f32x4 r = x * (sc[64 * j] + 1.0f) + sh[64 * j]; u32x2v w; w.x = pkbf(r[0], r[1]); w.y = pkbf(r[2], r[3]); o[64 * j] = w; } }
    }
}

__device__ __forceinline__ void prep_ab(Frame& F, const Args& A, int layer, int j) {
    LANE_VARS;
    const int gw = F.vcu * NWAVES + wave_, NGW = F.G * NWAVES;
    bf16* PROJ = (bf16*)(A.ws + WS_PROJ); const float* ROPE = (const float*)(A.ws + WS_ROPE);
    bf16* KL = (bf16*)(A.ws + WS_KLAB) + (size_t)j * 2 * LKV * 512;
    float* outk = A.out + out_k_off(layer);
    const int l16 = lane_ & 15, hg = lane_ >> 4;
    float qg[8], kg[8];
    { const f32x4* q4 = (const f32x4*)(A.in[22] + j * 128 + l16 * 8); const f32x4* k4 = (const f32x4*)(A.in[23] + j * 128 + l16 * 8); const f32x4 a = q4[0], b = q4[1], c = k4[0], d = k4[1];
#pragma unroll
      for (int e = 0; e < 4; ++e) { qg[e] = a[e]; qg[4 + e] = b[e]; kg[e] = c[e]; kg[4 + e] = d[e]; } }
    for (int row = gw; row < MTOK; row += NGW) {
        bf16* prow = PROJ + (size_t)row * AB_IN;
        const bool lat = row >= NCTX; const int t = (row - NCTX) & 2047, lbt = (row - NCTX) >> 11;
#pragma unroll
        for (int it = 0; it < 4; ++it) {
            const int head = it * 4 + hg; bf16* p = prow + 512 + head * 128 + l16 * 8;
            const v4u raw = *(const v4u*)p; float x[8]; unpack8(raw, x);
            float ss = 0.f;
#pragma unroll
            for (int e = 0; e < 8; ++e) ss += x[e] * x[e];
            ss += __shfl_xor(ss, 1); ss += __shfl_xor(ss, 2); ss += __shfl_xor(ss, 4); ss += __shfl_xor(ss, 8);
            const float rms = 1.0f / sqrtf(ss * (1.0f / 128.0f) + RMS_EPS);
#pragma unroll
            for (int e = 0; e < 8; ++e) x[e] = x[e] * rms * ((it == 3) ? kg[e] : qg[e]);
            if (lat) {
                const f32x4* cs4 = (const f32x4*)(ROPE + ((size_t)t * 64 + (l16 & 7) * 8) * 2);
#pragma unroll
                for (int e2 = 0; e2 < 4; ++e2) { const f32x4 cs = cs4[e2];
                    { const float pr = __shfl_xor(x[2 * e2], 8); x[2 * e2] = (l16 < 8) ? x[2 * e2] * cs[0] - pr * cs[1] : x[2 * e2] * cs[0] + pr * cs[1]; }
                    { const float pr = __shfl_xor(x[2 * e2 + 1], 8); x[2 * e2 + 1] = (l16 < 8) ? x[2 * e2 + 1] * cs[2] - pr * cs[3] : x[2 * e2 + 1] * cs[2] + pr * cs[3]; } }
            }
            const v4u o = pack8(x);
            if (it < 3) *(v4u*)p = o;
            else if (!lat) { *(v4u*)p = o; float* ok = outk + (size_t)row * 512 + hg * 128 + l16 * 8;
                *(f32x4*)ok = (f32x4){x[0], x[1], x[2], x[3]}; *(f32x4*)(ok + 4) = (f32x4){x[4], x[5], x[6], x[7]}; }
            else *(v4u*)(KL + ((size_t)(lbt * LKV + t)) * 512 + hg * 128 + l16 * 8) = o;
        }
    }
    {
        const int r32 = lane_ & 31, hi = lane_ >> 5;
        const bf16* PW = (const bf16*)(A.ws + WS_POOLW) + (size_t)j * 4 * 128 * 128; const float* ps = A.in[21] + j * 512; bf16* MIX = (bf16*)(A.ws + WS_MIX);
        for (int task = gw; task < (MTOK / 32) * 4; task += NGW) {
            const int rb = task >> 2, g = task & 3, w = 2 << g, row = rb * 32 + r32;
            int seq0, L, t; if (row < NCTX) { seq0 = row & ~255; L = 256; t = row & 255; } else { seq0 = NCTX + ((row - NCTX) & ~2047); L = 2048; t = (row - NCTX) & 2047; }
            const int lo = max(t - w / 2, 0), hi_ = min(t - w / 2 + w - 1, L - 1); const float inv = 1.0f / (float)(hi_ - lo + 1);
            float s[8][8];
#pragma unroll
            for (int d0 = 0; d0 < 8; ++d0)
#pragma unroll
                for (int e = 0; e < 8; ++e) s[d0][e] = 0.f;
            const bf16* cbase = PROJ + g * 128 + hi * 8;
            for (int rr = lo; rr <= hi_; ++rr) { const bf16* pr = cbase + (size_t)(seq0 + rr) * AB_IN;
#pragma unroll
                for (int d0 = 0; d0 < 8; ++d0) { const v4u raw = *(const v4u*)(pr + d0 * 16); float x[8]; unpack8(raw, x);
#pragma unroll
                    for (int e = 0; e < 8; ++e) s[d0][e] += x[e]; } }
            att::bf16x8 Bf[8];
            { const bf16* pr = cbase + (size_t)row * AB_IN;
#pragma unroll
              for (int d0 = 0; d0 < 8; ++d0) { const v4u raw = *(const v4u*)(pr + d0 * 16); float x[8]; unpack8(raw, x);
#pragma unroll
                  for (int e = 0; e < 8; ++e) x[e] = s[d0][e] * inv - x[e];
                  const v4u o = pack8(x); Bf[d0] = __builtin_bit_cast(att::bf16x8, o); } }
#pragma unroll
            for (int nb = 0; nb < 4; ++nb) {
                f32x16 acc = {};
                const bf16* wrow = PW + ((size_t)g * 128 + nb * 32 + r32) * 128 + hi * 8;
#pragma unroll
                for (int d0 = 0; d0 < 8; ++d0) { const att::bf16x8 a = *(const att::bf16x8*)(wrow + d0 * 16); acc = __builtin_amdgcn_mfma_f32_32x32x16_bf16(a, Bf[d0], acc, 0, 0, 0); }
#pragma unroll
                for (int q = 0; q < 4; ++q) { const int n0 = nb * 32 + 8 * q + 4 * hi; const f32x4 sc4 = *(const f32x4*)(ps + g * 128 + n0);
                    u32x2v o; o.x = pkbf(acc[4 * q] * sc4[0], acc[4 * q + 1] * sc4[1]); o.y = pkbf(acc[4 * q + 2] * sc4[2], acc[4 * q + 3] * sc4[3]);
                    *(u32x2v*)(MIX + (size_t)row * DM + g * 128 + n0) = o; }
            }
        }
    }
}

__device__ __forceinline__ void prep_cd(Frame& F, const Args& A, int j) {
    LANE_VARS;
    const int gt = F.vcu * (NWAVES * 64) + tid_, NT = F.G * NWAVES * 64;
    const bf16* PROJ = (const bf16*)(A.ws + WS_PROJ); bf16* MIX = (bf16*)(A.ws + WS_MIX); const float* cw = A.in[27] + (size_t)j * 3 * 512;
    for (int idx = gt; idx < MTOK * 64; idx += NT) {
        const int row = idx >> 6, ch = (idx & 63) * 8;
        int L, t; if (row < NCTX) { L = 256; t = row & 255; } else { L = 2048; t = (row - NCTX) & 2047; }
        const bf16* pr = PROJ + (size_t)row * CD_IN + ch;
        float xi[8], gc[8], gb[8], u0[8], u1[8], u2[8];
        unpack8(*(const v4u*)(pr + 4608), xi); unpack8(*(const v4u*)(pr + 5632), gc); unpack8(*(const v4u*)(pr + 5120), gb);
#pragma unroll
        for (int e = 0; e < 8; ++e) u1[e] = gc[e] * xi[e];
        if (t > 0) { unpack8(*(const v4u*)(pr - CD_IN + 4608), xi); unpack8(*(const v4u*)(pr - CD_IN + 5632), gc);
#pragma unroll
            for (int e = 0; e < 8; ++e) u0[e] = gc[e] * xi[e]; }
        else {
#pragma unroll
            for (int e = 0; e < 8; ++e) u0[e] = 0.f; }
        if (t < L - 1) { unpack8(*(const v4u*)(pr + CD_IN + 4608), xi); unpack8(*(const v4u*)(pr + CD_IN + 5632), gc);
#pragma unroll
            for (int e = 0; e < 8; ++e) u2[e] = gc[e] * xi[e]; }
        else {
#pragma unroll
            for (int e = 0; e < 8; ++e) u2[e] = 0.f; }
        const f32x4 w0a = *(const f32x4*)(cw + ch), w0b = *(const f32x4*)(cw + ch + 4), w1a = *(const f32x4*)(cw + 512 + ch), w1b = *(const f32x4*)(cw + 512 + ch + 4), w2a = *(const f32x4*)(cw + 1024 + ch), w2b = *(const f32x4*)(cw + 1024 + ch + 4);
        float y[8];
#pragma unroll
        for (int e = 0; e < 4; ++e) { y[e] = gb[e] * (w0a[e] * u0[e] + w1a[e] * u1[e] + w2a[e] * u2[e]); y[4 + e] = gb[4 + e] * (w0b[e] * u0[4 + e] + w1b[e] * u1[4 + e] + w2b[e] * u2[4 + e]); }
        *(v4u*)(MIX + (size_t)row * DM + 1536 + ch) = pack8(y);
    }
}

__device__ __forceinline__ void attn_phase(Frame& F, const Args& A, int layer, int j, bool even) {
    LANE_VARS;
    const bf16* PROJ = (const bf16*)(A.ws + WS_PROJ); bf16* MIX = (bf16*)(A.ws + WS_MIX);
    gu32* ctr = F.ctl + CW_Q + 64 * layer;
    const int ldq = even ? AB_IN : CD_IN, qcol0 = even ? 512 : 0, kcol0 = even ? 2048 : 1536, vcol0 = even ? 2560 : 3072, mixcol0 = even ? 512 : 0, ldl = even ? 512 : 1536;
    const bf16* KL = even ? (const bf16*)(A.ws + WS_KLAB) + (size_t)j * 2 * LKV * 512 : (const bf16*)(A.ws + WS_KLCD) + (size_t)j * 2 * LKV * 1536;
    const bf16* VL = even ? (const bf16*)(A.ws + WS_VLAB) + (size_t)j * 2 * LKV * 512 : (const bf16*)(A.ws + WS_VLCD) + (size_t)j * 2 * LKV * 1536;
    const float* rpb = A.in[26] + (size_t)j * 12 * 465;
    constexpr int NLONG = 2 * 12 * 8, NUNITS = NLONG + 32 * 12;
    for (;;) {
        if (tid_ == 0) F.MISC[0] = __hip_atomic_fetch_add(ctr, 1u, __ATOMIC_RELAXED, __HIP_MEMORY_SCOPE_AGENT);
        __syncthreads();
        const int u = (int)F.MISC[0];
        __syncthreads();
        if (u >= NUNITS) break;
        att::AUnit U;
        if (u < NLONG) {
            const int b = u / 96, rem = u % 96, h = rem >> 3, qb = rem & 7, kvh = even ? h / 3 : h;
            const size_t row0 = (size_t)NCTX + b * LSEQ + qb * 256;
            U.Q = PROJ + row0 * ldq + qcol0 + h * 128; U.ldq = ldq;
            U.K = KL + (size_t)b * LKV * ldl + kvh * 128; U.V = VL + (size_t)b * LKV * ldl + kvh * 128; U.ldk = ldl;
            U.O = MIX + row0 * DM + mixcol0 + h * 128; U.ldo = DM; U.rpb = rpb + h * 465;
            if (even) { U.ntiles = LKV / 64; U.nband = 0; U.band0 = 0; U.ctx0 = 0; U.qrow0 = 0; }
            else { const int b0 = min(max(4 * qb - 4, 0), 24), last = min(max(4 * qb - 1, 0), 24) + 7;
                U.nband = last - b0 + 1; U.band0 = b0; U.ctx0 = LSEQ; U.ntiles = U.nband + PAST / 64; U.qrow0 = 4 * qb; }
        } else {
            const int v = u - NLONG, b = v / 12, h = v % 12, kvh = even ? h / 3 : h;
            const size_t row0 = (size_t)b * 256;
            U.Q = PROJ + row0 * ldq + qcol0 + h * 128; U.ldq = ldq;
            U.K = PROJ + row0 * ldq + kcol0 + kvh * 128; U.V = PROJ + row0 * ldq + vcol0 + kvh * 128; U.ldk = ldq;
            U.O = MIX + row0 * DM + mixcol0 + h * 128; U.ldo = DM; U.rpb = rpb;
            U.ntiles = 4; U.nband = 0; U.band0 = 0; U.ctx0 = 0; U.qrow0 = 0;
        }
        att::attn_unit(U, F.ldsg);
    }
}

#define IN(k) (lo <= (k) && (k) < hi)
#define SEAM(k) do { if (IN(k) && IN((k) + 1)) xcd_barrier(bar); } while (0)
template <int I>
__device__ __forceinline__ void run_layer(Frame& F, const Args& args, const XcdBarrier& bar, const int lo, const int hi) {
    constexpr int pb = 2 + 8 * I, j = I >> 1; constexpr bool even = !(I & 1);
    unsigned char* ws = args.ws;
    bf16* H = (bf16*)(ws + WS_H); bf16* PROJ = (bf16*)(ws + WS_PROJ); bf16* MIX = (bf16*)(ws + WS_MIX);
    float* Y = (float*)(ws + WS_Y); float* X = (float*)(ws + WS_X); float* MOD = (float*)(ws + WS_MOD);
    const float* modl = MOD + (size_t)I * 3 * 12288;
    if (IN(pb + 0)) {
        constexpr int N = even ? AB_IN : CD_IN;
        const bf16* Wt = even ? (const bf16*)(ws + WS_WINAB) + (size_t)j * AB_IN * DM : (const bf16*)(ws + WS_WINCD) + (size_t)j * CD_IN * DM;
        pg8::Gemm g{H, Wt, MTOK, N, DM}; pg8::StaticOrder S; S.init(MTOK, N, F.G, (int)blockIdx.x);
        pg8::EpiProj E;
        E.O = PROJ; E.ldc = N;
        if (even) { E.lo = 2560; E.mid = 3072; E.hi = 3072; E.R0 = (bf16*)(ws + WS_VLAB) + (size_t)j * 2 * LKV * 512; E.R1 = E.R0; E.rld = 512; E.F0 = args.out + out_v_off(I); E.F1 = E.F0; }
        else { E.lo = 1536; E.mid = 3072; E.hi = 4608; E.R0 = (bf16*)(ws + WS_KLCD) + (size_t)j * 2 * LKV * 1536; E.R1 = (bf16*)(ws + WS_VLCD) + (size_t)j * 2 * LKV * 1536; E.rld = 1536;
            E.F0 = args.out + out_k_off(I); E.F1 = args.out + out_v_off(I); }
        pg8::gemm_phase<pg8::EpiProj, pg8::StaticOrder, true, true>(F.lds + RING_OFF, g, S, E);
    }
    SEAM(pb + 0);
    if (IN(pb + 1)) { if (even) prep_ab(F, args, I, j); else prep_cd(F, args, j); }
    SEAM(pb + 1);
    if (IN(pb + 2)) { attn_phase(F, args, I, j, even); }
    SEAM(pb + 2);
    if (IN(pb + 3)) {
        const float* XA = (I == 0) ? args.in[0] : X; const float* XB = (I == 0) ? args.in[1] : X + (size_t)NCTX * DM;
        const bf16* Wt = even ? (const bf16*)(ws + WS_WOUTAB) + (size_t)j * DM * DM : (const bf16*)(ws + WS_WOUTCD) + (size_t)j * DM * DM;
        pg8::Gemm g{MIX, Wt, MTOK, DM, DM}; pg8::StaticOrder S; S.init(MTOK, DM, F.G, (int)blockIdx.x);
        pg8::EpiRes E{XA, XB, Y, modl + 4096, ALPHA_RES};
        pg8::gemm_phase<pg8::EpiRes, pg8::StaticOrder, true, true>(F.lds + RING_OFF, g, S, E);
    }
    SEAM(pb + 3);
    if (IN(pb + 4)) { ln_phase(F, Y, X, args.in[14] + I * DM, args.in[15] + I * DM, modl + 6144, H); }
    SEAM(pb + 4);
    if (IN(pb + 5)) {
        pg8::Gemm g{H, (const bf16*)(ws + WS_WGU) + (size_t)I * NGU * DM, MTOK, NGU, DM}; pg8::StaticOrder S; S.init(MTOK, NGU, F.G, (int)blockIdx.x);
        pg8::EpiGU E{PROJ};
        pg8::gemm_phase<pg8::EpiGU, pg8::StaticOrder, true, true>(F.lds + RING_OFF, g, S, E);
    }
    SEAM(pb + 5);
    if (IN(pb + 6)) {
        pg8::Gemm g{PROJ, (const bf16*)(ws + WS_WDN) + (size_t)I * DM * FFH, MTOK, DM, FFH}; pg8::StaticOrder S; S.init(MTOK, DM, F.G, (int)blockIdx.x);
        pg8::EpiRes E{X, X + (size_t)NCTX * DM, Y, modl + 10240, ALPHA_RES};
        pg8::gemm_phase<pg8::EpiRes, pg8::StaticOrder, true, true>(F.lds + RING_OFF, g, S, E);
    }
    SEAM(pb + 6);
    if (IN(pb + 7)) {
        if (I < 3) ln_phase(F, Y, X, args.in[16] + I * DM, args.in[17] + I * DM, modl + 3 * 12288, H);
        else ln_phase(F, Y, args.out, args.in[16] + I * DM, args.in[17] + I * DM, nullptr, H);
    }
    if (I < 3) SEAM(pb + 7);
}

__global__ void __launch_bounds__(NWAVES * 64, 2) mk_fwd(Args args) {
    extern __shared__ __attribute__((aligned(16))) unsigned char lds[];
    Frame F;
    F.lds = (LAS unsigned char*)lds; F.ldsg = (char*)lds;
    F.MISC = (volatile LAS unsigned*)(F.lds + MISC_OFF);
    F.G = gridDim.x; { const int bx = blockIdx.x; F.vcu = (F.G % 8 == 0) ? (bx % 8) * (F.G / 8) + bx / 8 : bx; }
    F.ctl = (gu32*)(args.ws + WS_CTL);
    for (int u = threadIdx.x; u < (LDS_BYTES - LDSCTL_OFF) / 4; u += NWAVES * 64) ((LAS unsigned*)(F.lds + LDSCTL_OFF))[u] = 0u;
    __syncthreads();
    const int lo = args.ph_lo, hi = args.ph_hi;
    XcdBarrier bar; bar.bar = (unsigned*)(F.ctl + CW_BAR); bar.x = 0; bar.st = nullptr;
    if (hi - lo > 1) bar = xcd_barrier_post((unsigned*)(F.ctl + CW_BAR), F.MISC + 8);

    if (IN(0)) { p0_prologue(F, args); }
    SEAM(0);
    if (IN(1)) { p1_modulate_x(F, args); }
    SEAM(1);
    run_layer<0>(F, args, bar, lo, hi);
    run_layer<1>(F, args, bar, lo, hi);
    run_layer<2>(F, args, bar, lo, hi);
    run_layer<3>(F, args, bar, lo, hi);
}
#undef IN
#undef SEAM

extern "C" void kernel_launch(void* const* d_in, const int* in_sizes, int n_in, void* d_out, int out_size, void* d_ws, size_t ws_size, hipStream_t stream) {
    static int grid = 0;
    if (grid == 0) {
        if (n_in != 31 || (size_t)out_size != OUT_TOTAL || ws_size < WS_END) { fprintf(stderr, "kernel_launch: unexpected shapes: n_in %d out %d ws %zu (need %zu)\n", n_in, out_size, ws_size, (size_t)WS_END); grid = -1; return; }
        int dev = 0, cus = 0, per_cu = 0;
        if (hipGetDevice(&dev) != hipSuccess || hipDeviceGetAttribute(&cus, hipDeviceAttributeMultiprocessorCount, dev) != hipSuccess) { grid = -1; return; }
        if (hipFuncSetAttribute((const void*)mk_fwd, hipFuncAttributeMaxDynamicSharedMemorySize, LDS_BYTES) != hipSuccess) { fprintf(stderr, "kernel_launch: hipFuncSetAttribute failed\n"); grid = -1; return; }
        if (hipOccupancyMaxActiveBlocksPerMultiprocessor(&per_cu, (const void*)mk_fwd, NWAVES * 64, LDS_BYTES) != hipSuccess || per_cu < 1) fprintf(stderr, "kernel_launch: occupancy query reports %d\n", per_cu);
        (void)hipGetLastError();
        grid = cus;
    }
    if (grid < 0) return;
    if (hipMemsetAsync((char*)d_ws + WS_CTL, 0, CTL_ZERO_BYTES, stream) != hipSuccess) return;
    Args a{};
    for (int i = 0; i < 31; ++i) a.in[i] = (const float*)d_in[i];
    a.out = (float*)d_out; a.ws = (unsigned char*)d_ws;
#if MK_PER_PHASE
    for (int p = 0; p < NPHASES; ++p) { a.ph_lo = p; a.ph_hi = p + 1; hipLaunchKernelGGL(mk_fwd, dim3(grid), dim3(NWAVES * 64), LDS_BYTES, stream, a); }
#else
    a.ph_lo = 0; a.ph_hi = NPHASES; hipLaunchKernelGGL(mk_fwd, dim3(grid), dim3(NWAVES * 64), LDS_BYTES, stream, a);
#endif
    const hipError_t le = hipPeekAtLastError();
    if (le != hipSuccess) fprintf(stderr, "kernel_launch: launch failed: %s\n", hipGetErrorName(le));
}
```

```cpp
#include <hip/hip_runtime.h>
#include <cstdio>
#include <cstdint>

#ifndef MK_PER_PHASE
#define MK_PER_PHASE 0
#endif

constexpr int DM = 2048, NCTX = 8192, NLAT = 4096, MTOK = NCTX + NLAT, FFH = 5632, NGU = 2 * FFH;
constexpr int LSEQ = 2048, PAST = 256, LKV = LSEQ + PAST;
constexpr int AB_IN = 3072, CD_IN = 6144;
constexpr float ALPHA_RES = 1.6817928305074292f;
constexpr float LN_EPS = 1e-5f, RMS_EPS = 1e-6f;
namespace pg8 {
#define PG8_LAS __attribute__((address_space(3)))
typedef unsigned short bf16_t;
typedef short bf16x8 __attribute__((ext_vector_type(8)));
typedef float f32x4 __attribute__((ext_vector_type(4)));
typedef unsigned u32x4 __attribute__((ext_vector_type(4)));
constexpr int BM = 256, BK = 64, HALF = 128, HTB = HALF * BK * 2  , STAGE_BYTES = 8 * HTB, NXCD = 8, WGM = 8;

__host__ __device__ __forceinline__ int lds_byte(int r, int c) { const int st = (r >> 4) * 2 + (c >> 5), rr = r & 15, cc = c & 31, ob = rr * 64 + cc * 2; return st * 1024 + (ob ^ (((ob >> 9) & 1) << 5)); }
__host__ __device__ __forceinline__ void stage_rc(int b, int& R, int& C) { const int st = b / 1024, sb = b % 1024, swz = sb ^ (((sb >> 9) & 1) << 5); R = (st >> 1) * 16 + swz / 64; C = (st & 1) * 32 + (swz % 64) / 2; }
__host__ __device__ __forceinline__ int perm32(int rho) { const int n = rho >> 4, i = rho & 15; return 8 * (i >> 2) + 4 * n + (i & 3); }

struct Unit { int pm, pn, ko; };
struct Gemm { const bf16_t* A; const bf16_t* Bt; int M, N, K, ld; };

struct StaticOrder {
    int nM, nN, nwg, G, c, per, klen;
    __host__ __device__ void init(int M, int N, int G_, int c_, int ks_ = 1, int klen_ = 0) { nM = M / BM; nN = N / BM; per = nM * nN; nwg = per * ks_; G = G_; c = c_; klen = klen_; }
    __host__ __device__ bool next(int i, Unit& u) const {
        const long L = (long)i * G + c; if (L >= nwg) return false;
        int wgid = (int)L; { const int q = nwg / NXCD, r = nwg % NXCD, xcd = wgid % NXCD, off = wgid / NXCD; wgid = (xcd < r ? xcd * (q + 1) : r * (q + 1) + (xcd - r) * q) + off; }
        const int kh = wgid / per; wgid -= kh * per; u.ko = kh * klen;
        const int nig = WGM * nN, gid = wgid / nig, fm = gid * WGM, gsz = (nM - fm) < WGM ? (nM - fm) : WGM;
        u.pm = fm + ((wgid % nig) % gsz); u.pn = (wgid % nig) / gsz; return true;
    }
    __device__ __forceinline__ void a_ready(const Unit&) const {}
    __device__ __forceinline__ void done(const Unit&) const {}
};

__device__ __forceinline__ unsigned cvt_pk_bf16(float lo, float hi) { unsigned r; asm volatile("v_cvt_pk_bf16_f32 %0, %1, %2" : "=v"(r) : "v"(lo), "v"(hi)); return r; }
typedef float f32x2 __attribute__((ext_vector_type(2)));

__device__ __forceinline__ int panel_cond(int pm) { return pm < 32 ? 0 : (pm < 40 ? 1 : 2); }

struct EpiProj {
    static constexpr bool PERM = true, AFTER_DRAIN = false;
    bf16_t* O; int ldc; int lo, mid, hi; bf16_t* R0; bf16_t* R1; int rld; float* F0; float* F1;
    __device__ __forceinline__ void operator()(const f32x4 (&acc)[2][2][4][2], const Unit& u, int wr, int wc, int fr, int fq) const {
        const int colt = u.pn * BM, cl = wc * 32 + 8 * fq, rl = wr * 64 + fr;
        const bool inr = colt >= lo && colt < hi; const int t = (colt >= mid) ? 1 : 0; const int cbase = colt - (t ? mid : lo);
        if (inr && u.pm >= 32) {
            bf16_t* R = t ? R1 : R0; const int lb = (u.pm - 32) >> 3, t0 = ((u.pm - 32) & 7) * 256;
            bf16_t* base = R + (size_t)(lb * 2304 + t0 + rl) * rld + cbase + cl;
#pragma unroll
            for (int ai = 0; ai < 2; ++ai)
#pragma unroll
                for (int m = 0; m < 4; ++m) { bf16_t* rowp = base + (size_t)(ai * HALF + m * 16) * rld;
#pragma unroll
                    for (int bj = 0; bj < 2; ++bj) { const f32x4 v0 = acc[ai][bj][m][0], v1 = acc[ai][bj][m][1];
                        u32x4 w; w.x = cvt_pk_bf16(v0[0], v0[1]); w.y = cvt_pk_bf16(v0[2], v0[3]); w.z = cvt_pk_bf16(v1[0], v1[1]); w.w = cvt_pk_bf16(v1[2], v1[3]);
                        *(u32x4*)(rowp + bj * HALF) = w; } }
        } else {
            bf16_t* base = O + (size_t)(u.pm * BM + rl) * ldc + colt + cl;
#pragma unroll
            for (int ai = 0; ai < 2; ++ai)
#pragma unroll
                for (int m = 0; m < 4; ++m) { bf16_t* rowp = base + (size_t)(ai * HALF + m * 16) * ldc;
#pragma unroll
                    for (int bj = 0; bj < 2; ++bj) { const f32x4 v0 = acc[ai][bj][m][0], v1 = acc[ai][bj][m][1];
                        u32x4 w; w.x = cvt_pk_bf16(v0[0], v0[1]); w.y = cvt_pk_bf16(v0[2], v0[3]); w.z = cvt_pk_bf16(v1[0], v1[1]); w.w = cvt_pk_bf16(v1[2], v1[3]);
                        *(u32x4*)(rowp + bj * HALF) = w; } }
            float* Fp = t ? F1 : F0;
            if (inr && Fp) {
                float* fb = Fp + (size_t)(u.pm * BM + rl) * rld + cbase + cl;
#pragma unroll
                for (int ai = 0; ai < 2; ++ai)
#pragma unroll
                    for (int m = 0; m < 4; ++m) { float* rowp = fb + (size_t)(ai * HALF + m * 16) * rld;
#pragma unroll
                        for (int bj = 0; bj < 2; ++bj) { *(f32x4*)(rowp + bj * HALF) = acc[ai][bj][m][0]; *(f32x4*)(rowp + bj * HALF + 4) = acc[ai][bj][m][1]; } }
            }
        }
    }
};

struct EpiD {
    static constexpr bool PERM = true, AFTER_DRAIN = false;
    bf16_t* D; bf16_t* D2; const float* gate;
    __device__ __forceinline__ void operator()(const f32x4 (&acc)[2][2][4][2], const Unit& u, int wr, int wc, int fr, int fq) const {
        const float* gv = gate + panel_cond(u.pm) * 12288 + u.pn * BM + wc * 32 + 8 * fq;
        bf16_t* base = (u.ko ? D2 : D) + (size_t)(u.pm * BM + wr * 64 + fr) * 2048 + u.pn * BM + wc * 32 + 8 * fq;
        f32x4 g4[2][2];
#pragma unroll
        for (int bj = 0; bj < 2; ++bj)
#pragma unroll
            for (int n = 0; n < 2; ++n) g4[bj][n] = *(const f32x4*)(gv + bj * HALF + 4 * n);
#pragma unroll
        for (int ai = 0; ai < 2; ++ai)
#pragma unroll
            for (int m = 0; m < 4; ++m) { bf16_t* rowp = base + (size_t)(ai * HALF + m * 16) * 2048;
#pragma unroll
                for (int bj = 0; bj < 2; ++bj) { const f32x4 v0 = acc[ai][bj][m][0] * g4[bj][0], v1 = acc[ai][bj][m][1] * g4[bj][1];
                    u32x4 w; w.x = cvt_pk_bf16(v0[0], v0[1]); w.y = cvt_pk_bf16(v0[2], v0[3]); w.z = cvt_pk_bf16(v1[0], v1[1]); w.w = cvt_pk_bf16(v1[2], v1[3]);
                    *(u32x4*)(rowp + bj * HALF) = w; } }
    }
};

struct EpiGU {
    static constexpr bool PERM = true, AFTER_DRAIN = false;
    bf16_t* ACT;
    static __device__ __forceinline__ float silu_mul(float g, float up) { const float e = __builtin_amdgcn_exp2f(g * -1.4426950408889634f); return g * __builtin_amdgcn_rcpf(1.0f + e) * up; }
    __device__ __forceinline__ void operator()(const f32x4 (&acc)[2][2][4][2], const Unit& u, int wr, int wc, int fr, int fq) const {
        bf16_t* base = ACT + (size_t)(u.pm * BM + wr * 64 + fr) * 5632 + u.pn * HALF + wc * 32 + 8 * fq;
#pragma unroll
        for (int ai = 0; ai < 2; ++ai)
#pragma unroll
            for (int m = 0; m < 4; ++m) { const f32x4 g0 = acc[ai][0][m][0], g1 = acc[ai][0][m][1], u0 = acc[ai][1][m][0], u1 = acc[ai][1][m][1];
                u32x4 w; w.x = cvt_pk_bf16(silu_mul(g0[0], u0[0]), silu_mul(g0[1], u0[1])); w.y = cvt_pk_bf16(silu_mul(g0[2], u0[2]), silu_mul(g0[3], u0[3]));
                w.z = cvt_pk_bf16(silu_mul(g1[0], u1[0]), silu_mul(g1[1], u1[1])); w.w = cvt_pk_bf16(silu_mul(g1[2], u1[2]), silu_mul(g1[3], u1[3]));
                *(u32x4*)(base + (size_t)(ai * HALF + m * 16) * 5632) = w; }
    }
};

template <class Epi, class Sched, bool ALIGN_EPI = false, bool SP2 = false>
__device__ __forceinline__ void gemm_phase(PG8_LAS unsigned char* lds, const Gemm g, const Sched& S, const Epi& E) {
    int tid = threadIdx.x; asm volatile("" : "+v"(tid));
    const int wid = __builtin_amdgcn_readfirstlane(tid >> 6), lane = tid & 63, wr = wid >> 2, wc = wid & 3, fr = lane & 15, fq = lane >> 4;
    const int K = g.K, LD = g.ld, nt = K / BK;
    unsigned voffA[2], voffB[2];
#pragma unroll
    for (int i = 0; i < 2; ++i) { int R, C; stage_rc(tid * 16 + i * 8192, R, C); const int Rb = Epi::PERM ? ((R & ~31) + perm32(R & 31)) : R;
        voffA[i] = (unsigned)(R * LD + C) * 2u; voffB[i] = (unsigned)(Rb * LD + C) * 2u; }
    const size_t kstep = (size_t)(BK * 2);
    const size_t hstep = (size_t)HALF * LD * 2;
    const size_t tstep = 2 * hstep;
    const unsigned ldsw = (unsigned)wid * 1024u;
    const int aoff = lds_byte(wr * 64 + fr, fq * 8), boff = lds_byte(wc * 32 + fr, fq * 8);
#define PG8_SA(b, h) (((b) * 2 + (h)) * HTB)
#define PG8_SB(b, h) ((4 + (b) * 2 + (h)) * HTB)
#define PG8_STAGE(bufoff, gbase, voff) do { _Pragma("unroll") for (int _i = 0; _i < 2; ++_i) \
        __builtin_amdgcn_global_load_lds((const unsigned*)((const char*)(gbase) + (voff)[_i]), (PG8_LAS unsigned*)(lds + (bufoff) + ldsw + _i * 8192), 16, 0, 0); } while (0)
#define PG8_LDA(dst, b, h) do { _Pragma("unroll") for (int m = 0; m < 4; ++m) _Pragma("unroll") for (int k = 0; k < 2; ++k) dst[m][k] = *(const PG8_LAS bf16x8*)(lds + PG8_SA(b, h) + aoff + m * 2048 + k * 1024); } while (0)
#define PG8_LDB(dst, b, h) do { _Pragma("unroll") for (int n = 0; n < 2; ++n) _Pragma("unroll") for (int k = 0; k < 2; ++k) dst[n][k] = *(const PG8_LAS bf16x8*)(lds + PG8_SB(b, h) + boff + n * 2048 + k * 1024); } while (0)
#define PG8_MMA(ai, bj, At, Bt) do { __builtin_amdgcn_s_setprio(1); _Pragma("unroll") for (int m = 0; m < 4; ++m) _Pragma("unroll") for (int n = 0; n < 2; ++n) _Pragma("unroll") for (int k = 0; k < 2; ++k) \
        acc[ai][bj][m][n] = __builtin_amdgcn_mfma_f32_16x16x32_bf16(Bt[n][k], At[m][k], acc[ai][bj][m][n], 0, 0, 0); __builtin_amdgcn_s_setprio(0); } while (0)
#define PG8_WAIT_V(n) asm volatile("s_waitcnt vmcnt(" #n ")" ::: "memory")
#define PG8_WAIT_L(n) asm volatile("s_waitcnt lgkmcnt(" #n ")" ::: "memory")
#define PG8_BAR __builtin_amdgcn_s_barrier()
#define PG8_SCHED __builtin_amdgcn_sched_barrier(0)
    Unit cur, nxt; int ui = 0;
    if (!S.next(0, cur)) return;
    f32x4 acc[2][2][4][2];
#pragma unroll
    for (int a = 0; a < 2; ++a)
#pragma unroll
        for (int b = 0; b < 2; ++b)
#pragma unroll
            for (int m = 0; m < 4; ++m)
#pragma unroll
                for (int n = 0; n < 2; ++n) acc[a][b][m][n] = (f32x4){0.f, 0.f, 0.f, 0.f};
    bf16x8 At[4][2], B0[2][2], B1[2][2];
    const char* cA = (const char*)g.A + (size_t)cur.pm * tstep + (size_t)cur.ko * 2; const char* cB = (const char*)g.Bt + (size_t)cur.pn * tstep + (size_t)cur.ko * 2;
    S.a_ready(cur);
    if constexpr (SP2) {
        PG8_STAGE(PG8_SB(0, 0), cB, voffB); PG8_STAGE(PG8_SB(0, 1), cB + hstep, voffB); PG8_STAGE(PG8_SA(0, 0), cA, voffA); PG8_STAGE(PG8_SA(0, 1), cA + hstep, voffA);
        if (wr == 1) PG8_BAR;
        PG8_WAIT_V(2); PG8_BAR;
        PG8_STAGE(PG8_SB(1, 0), cB + kstep, voffB); PG8_STAGE(PG8_SA(1, 0), cA + kstep, voffA); PG8_STAGE(PG8_SB(1, 1), cB + hstep + kstep, voffB);
        PG8_WAIT_V(6); PG8_BAR;
    } else {
        PG8_STAGE(PG8_SB(0, 0), cB, voffB); PG8_STAGE(PG8_SA(0, 0), cA, voffA); PG8_STAGE(PG8_SB(0, 1), cB + hstep, voffB); PG8_STAGE(PG8_SA(0, 1), cA + hstep, voffA);
        if (wr == 1) PG8_BAR;
        PG8_WAIT_V(4); PG8_BAR;
        PG8_STAGE(PG8_SB(1, 0), cB + kstep, voffB); PG8_STAGE(PG8_SA(1, 0), cA + kstep, voffA); PG8_STAGE(PG8_SB(1, 1), cB + hstep + kstep, voffB);
        PG8_WAIT_V(6); PG8_BAR;
    }
    for (;;) {
        const bool has_next = S.next(ui + 1, nxt);
        const char* nA = has_next ? (const char*)g.A + (size_t)nxt.pm * tstep + (size_t)nxt.ko * 2 : cA; const char* nB = has_next ? (const char*)g.Bt + (size_t)nxt.pn * tstep + (size_t)nxt.ko * 2 : cB;
        for (int t = 0; t < nt; t += 2) {
            const bool last = (t == nt - 2);
            const char* a1 = cA + (size_t)(t + 1) * kstep;
            const char* a2 = last ? nA : cA + (size_t)(t + 2) * kstep; const char* b2 = last ? nB : cB + (size_t)(t + 2) * kstep;
            const char* a3 = a2 + kstep; const char* b3 = b2 + kstep;
            if (last && has_next) S.a_ready(nxt);
            if constexpr (SP2) {
            PG8_LDB(B0, 0, 0); PG8_LDB(B1, 0, 1); PG8_SCHED; PG8_LDA(At, 0, 0); PG8_STAGE(PG8_SA(1, 1), a1 + hstep, voffA);
            PG8_WAIT_V(8); PG8_WAIT_L(0); PG8_BAR; PG8_MMA(0, 0, At, B0); PG8_MMA(0, 1, At, B1); PG8_BAR; PG8_SCHED;
            PG8_LDA(At, 0, 1); PG8_STAGE(PG8_SB(0, 0), b2, voffB); PG8_STAGE(PG8_SB(0, 1), b2 + hstep, voffB); PG8_STAGE(PG8_SA(0, 0), a2, voffA);
            PG8_WAIT_V(8); PG8_WAIT_L(0); PG8_BAR; PG8_MMA(1, 0, At, B0); PG8_MMA(1, 1, At, B1); PG8_BAR; PG8_SCHED;
            PG8_LDB(B0, 1, 0); PG8_LDB(B1, 1, 1); PG8_SCHED; PG8_LDA(At, 1, 0); PG8_STAGE(PG8_SA(0, 1), a2 + hstep, voffA);
            PG8_WAIT_V(8); PG8_WAIT_L(0); PG8_BAR; PG8_MMA(0, 0, At, B0); PG8_MMA(0, 1, At, B1); PG8_BAR; PG8_SCHED;
            PG8_LDA(At, 1, 1); PG8_STAGE(PG8_SB(1, 0), b3, voffB); PG8_STAGE(PG8_SB(1, 1), b3 + hstep, voffB); PG8_STAGE(PG8_SA(1, 0), a3, voffA);
            PG8_WAIT_V(8); PG8_WAIT_L(0); PG8_BAR; PG8_MMA(1, 0, At, B0); PG8_MMA(1, 1, At, B1); PG8_BAR; PG8_SCHED;
            } else {
            PG8_LDB(B0, 0, 0); PG8_SCHED; PG8_LDA(At, 0, 0); PG8_STAGE(PG8_SA(1, 1), a1 + hstep, voffA);
            PG8_WAIT_L(8); PG8_BAR; PG8_WAIT_L(0); PG8_MMA(0, 0, At, B0); PG8_BAR; PG8_SCHED;
            PG8_LDB(B1, 0, 1); PG8_STAGE(PG8_SB(0, 0), b2, voffB);
            PG8_BAR; PG8_WAIT_L(0); PG8_MMA(0, 1, At, B1); PG8_BAR;
            PG8_LDA(At, 0, 1); PG8_STAGE(PG8_SA(0, 0), a2, voffA);
            PG8_BAR; PG8_WAIT_L(0); PG8_MMA(1, 0, At, B0); PG8_BAR; PG8_SCHED;
            PG8_STAGE(PG8_SB(0, 1), b2 + hstep, voffB);
            PG8_WAIT_V(6); PG8_BAR; PG8_MMA(1, 1, At, B1); PG8_BAR;
            PG8_LDB(B0, 1, 0); PG8_SCHED; PG8_LDA(At, 1, 0); PG8_STAGE(PG8_SA(0, 1), a2 + hstep, voffA);
            PG8_WAIT_L(8); PG8_BAR; PG8_WAIT_L(0); PG8_MMA(0, 0, At, B0); PG8_BAR; PG8_SCHED;
            PG8_LDB(B1, 1, 1); PG8_STAGE(PG8_SB(1, 0), b3, voffB);
            PG8_BAR; PG8_WAIT_L(0); PG8_MMA(0, 1, At, B1); PG8_BAR;
            PG8_LDA(At, 1, 1); PG8_STAGE(PG8_SA(1, 0), a3, voffA);
            PG8_BAR; PG8_WAIT_L(0); PG8_MMA(1, 0, At, B0); PG8_BAR; PG8_SCHED;
            PG8_STAGE(PG8_SB(1, 1), b3 + hstep, voffB);
            PG8_WAIT_V(6); PG8_BAR; PG8_MMA(1, 1, At, B1); PG8_BAR;
            }
        }
        if constexpr (ALIGN_EPI) { if (wr == 0) PG8_BAR; }
        if constexpr (!Epi::AFTER_DRAIN) { E(acc, cur, wr, wc, fr, fq); S.done(cur); }
        if (!has_next) break;
#pragma unroll
        for (int a = 0; a < 2; ++a)
#pragma unroll
            for (int b = 0; b < 2; ++b)
#pragma unroll
                for (int m = 0; m < 4; ++m)
#pragma unroll
                    for (int n = 0; n < 2; ++n) acc[a][b][m][n] = (f32x4){0.f, 0.f, 0.f, 0.f};
        cur = nxt; cA = nA; cB = nB; ++ui;
        if constexpr (ALIGN_EPI) { if (wr == 1) PG8_BAR; }
    }
    PG8_WAIT_V(0);
    if constexpr (!ALIGN_EPI) { if (wr == 0) PG8_BAR; }
    PG8_BAR;
    if constexpr (Epi::AFTER_DRAIN) { E.fused(acc, cur, wr, wc, fr, fq, lds, wid, lane); S.done(cur); }
#undef PG8_SA
#undef PG8_SB
#undef PG8_STAGE
#undef PG8_LDA
#undef PG8_LDB
#undef PG8_MMA
#undef PG8_WAIT_V
#undef PG8_WAIT_L
#undef PG8_BAR
#undef PG8_SCHED
}
}

namespace att {
using bf16 = unsigned short;
constexpr int D = 128, NW = 8, QBLK = 32, KVBLK = 64;
constexpr float SCALE = 0.088388347648318440f;
constexpr float THR = 8.f;
constexpr int SHM_V = KVBLK * D * 2, SHM_K = KVBLK * D * 2;
constexpr int LDS_WS = 2 * SHM_V + 2 * SHM_K, LDS_RPB = LDS_WS + NW * 64 * 4, LDS_TOTAL = LDS_RPB + 2048;
using bf16x8 = __attribute__((ext_vector_type(8))) short;
using s16x4  = __attribute__((ext_vector_type(4))) short;
using f32x16 = __attribute__((ext_vector_type(16))) float;
using f32x8  = __attribute__((ext_vector_type(8))) float;
using u32x4  = __attribute__((ext_vector_type(4))) unsigned;
#define KSWZ(row, colB) ((row) * 256 + ((colB) ^ (((row) & 7) << 4)))
#define SBAR() __builtin_amdgcn_sched_barrier(0)
__device__ __forceinline__ int crow(int r, int hi) { return (r & 3) + 8 * (r >> 2) + 4 * hi; }
__device__ __forceinline__ unsigned cvtpk(float lo, float hi) {
  unsigned r; asm volatile("v_cvt_pk_bf16_f32 %0, %1, %2" : "=v"(r) : "v"(lo), "v"(hi)); return r;
}
template <typename TIn> struct Stage;
template <> struct Stage<bf16>  { using T = bf16x8;
  __device__ static __forceinline__ T ld8(const bf16* p) { return *reinterpret_cast<const bf16x8*>(p); }
  __device__ static __forceinline__ bf16x8 tobf(T x) { return x; } };
template <> struct Stage<float> { using T = f32x8;
  __device__ static __forceinline__ T ld8(const float* p) { return *reinterpret_cast<const f32x8*>(p); }
  __device__ static __forceinline__ bf16x8 tobf(T x) {
    u32x4 w = {cvtpk(x[0], x[1]), cvtpk(x[2], x[3]), cvtpk(x[4], x[5]), cvtpk(x[6], x[7])}; return *reinterpret_cast<bf16x8*>(&w); } };

__device__ __forceinline__ void partialSM(f32x16& p0, f32x16& p1, float& m_reg, float& mn, float& alpha) {
  constexpr float C = SCALE * 1.4426950408889634f;
  float pmax = p0[0]; for (int r = 1; r < 16; ++r) pmax = fmaxf(pmax, p0[r]); for (int r = 0; r < 16; ++r) pmax = fmaxf(pmax, p1[r]);
  { auto rr = __builtin_amdgcn_permlane32_swap(__float_as_uint(pmax), __float_as_uint(pmax), false, false);
    pmax = fmaxf(__uint_as_float(rr[0]), __uint_as_float(rr[1])); }
  if (__builtin_expect(__all(pmax - m_reg <= THR / SCALE), 1)) { mn = m_reg; alpha = 1.f; }
  else { mn = fmaxf(m_reg, pmax); alpha = __builtin_amdgcn_exp2f((m_reg - mn) * C); m_reg = mn; }
  float mnC = -mn * C;
  for (int r = 0; r < 16; ++r) p0[r] = fmaf(p0[r], C, mnC); for (int r = 0; r < 16; ++r) p1[r] = fmaf(p1[r], C, mnC);
  for (int r = 0; r < 16; ++r) p0[r] = __builtin_amdgcn_exp2f(p0[r]);
}
__device__ __forceinline__ void finishSM(f32x16& p0, f32x16& p1, float alpha, float& l_reg, bf16x8& pa0, bf16x8& pa1, bf16x8& pa2, bf16x8& pa3) {
  for (int r = 0; r < 16; ++r) p1[r] = __builtin_amdgcn_exp2f(p1[r]);
  float ps = 0; for (int r = 0; r < 16; ++r) ps += p0[r]; for (int r = 0; r < 16; ++r) ps += p1[r];
  { auto rr = __builtin_amdgcn_permlane32_swap(__float_as_uint(ps), __float_as_uint(ps), false, false);
    ps = __uint_as_float(rr[0]) + __uint_as_float(rr[1]); }
  l_reg = l_reg * alpha + ps;
#define PK4(P, BASE, OUT) do { unsigned a0 = cvtpk(P[BASE + 0], P[BASE + 1]), a1 = cvtpk(P[BASE + 2], P[BASE + 3]);   \
    unsigned b0 = cvtpk(P[BASE + 4], P[BASE + 5]), b1 = cvtpk(P[BASE + 6], P[BASE + 7]);                              \
    auto r0 = __builtin_amdgcn_permlane32_swap(a0, b0, false, false); auto r1 = __builtin_amdgcn_permlane32_swap(a1, b1, false, false); \
    u32x4 w = {r0[0], r1[0], r0[1], r1[1]}; OUT = *reinterpret_cast<bf16x8*>(&w); } while (0)
  PK4(p0, 0, pa0); PK4(p0, 8, pa1); PK4(p1, 0, pa2); PK4(p1, 8, pa3);
#undef PK4
}
__device__ __forceinline__ void qkt(f32x16& p0, f32x16& p1, const bf16* Ks, const bf16x8* qr, int r32, int hi) {
  p0 = f32x16{}; p1 = f32x16{};
  for (int d0 = 0; d0 < 8; ++d0) { int cb = (d0 * 16 + hi * 8) * 2;
    bf16x8 b0 = *reinterpret_cast<const bf16x8*>((const char*)Ks + KSWZ(r32, cb));
    bf16x8 b1 = *reinterpret_cast<const bf16x8*>((const char*)Ks + KSWZ(32 + r32, cb));
    p0 = __builtin_amdgcn_mfma_f32_32x32x16_bf16(b0, qr[d0], p0, 0, 0, 0);
    p1 = __builtin_amdgcn_mfma_f32_32x32x16_bf16(b1, qr[d0], p1, 0, 0, 0); }
}
__device__ __forceinline__ int v_st(int k, int c) { const int kk = (k & ~0xC) | ((k & 4) << 1) | ((k & 8) >> 1); return ((kk >> 3) * 4 + (c >> 5)) * 512 + ((kk & 7) * 32 + (c & 31)) * 2; }
__device__ __forceinline__ int v_rd_base(int lane) { return ((lane & 3) << 3) | (((lane >> 2) & 3) << 6) | (((lane >> 4) & 1) << 5) | (((lane >> 5) & 1) << 8); }
constexpr int v_rd_off(int d0, int ks, int half) { return d0 * 512 + ks * 4096 + half * 2048; }
template <int OFF> __device__ __forceinline__ s16x4 tr_read(int vb) {
  s16x4 r; asm volatile("ds_read_b64_tr_b16 %0, %1 offset:%2" : "=&v"(r) : "v"(vb), "i"(OFF) : "memory"); return r;
}
template <int D0> __device__ __forceinline__ void pv_one(f32x16& od, int vb, bf16x8 pa0, bf16x8 pa1, bf16x8 pa2, bf16x8 pa3) {
  const s16x4 l0 = tr_read<v_rd_off(D0, 0, 0)>(vb), h0 = tr_read<v_rd_off(D0, 0, 1)>(vb), l1 = tr_read<v_rd_off(D0, 1, 0)>(vb), h1 = tr_read<v_rd_off(D0, 1, 1)>(vb);
  const s16x4 l2 = tr_read<v_rd_off(D0, 2, 0)>(vb), h2 = tr_read<v_rd_off(D0, 2, 1)>(vb), l3 = tr_read<v_rd_off(D0, 3, 0)>(vb), h3 = tr_read<v_rd_off(D0, 3, 1)>(vb);
  asm volatile("s_waitcnt lgkmcnt(0)" ::: "memory"); SBAR();
#define PK(L, H) (bf16x8){L[0], L[1], L[2], L[3], H[0], H[1], H[2], H[3]}
  od = __builtin_amdgcn_mfma_f32_32x32x16_bf16(pa0, PK(l0, h0), od, 0, 0, 0);
  od = __builtin_amdgcn_mfma_f32_32x32x16_bf16(pa1, PK(l1, h1), od, 0, 0, 0);
  od = __builtin_amdgcn_mfma_f32_32x32x16_bf16(pa2, PK(l2, h2), od, 0, 0, 0);
  od = __builtin_amdgcn_mfma_f32_32x32x16_bf16(pa3, PK(l3, h3), od, 0, 0, 0);
#undef PK
}
__device__ __forceinline__ void pv_d0(f32x16* o, int vb, bf16x8 pa0, bf16x8 pa1, bf16x8 pa2, bf16x8 pa3) {
  pv_one<0>(o[0], vb, pa0, pa1, pa2, pa3); pv_one<1>(o[1], vb, pa0, pa1, pa2, pa3); pv_one<2>(o[2], vb, pa0, pa1, pa2, pa3); pv_one<3>(o[3], vb, pa0, pa1, pa2, pa3);
}
typedef float f32x4g __attribute__((ext_vector_type(4)));
struct AUnit {
    const bf16* Q; const bf16* K; const bf16* V; bf16* O; const float* rpb;
    const float* qg; const float* rope; int t0;
    int ldq, ldk, ldo, ntiles, nband, band0, ctx0, qrow0;
};
__device__ __forceinline__ unsigned short f2bf1(float v) { return (unsigned short)(cvtpk(v, v) & 0xffffu); }

__device__ __forceinline__ void attn_unit_dense(const AUnit& U, char* lds) {
  int tid = threadIdx.x; asm volatile("" : "+v"(tid));
  const int wid = __builtin_amdgcn_readfirstlane(tid >> 6), lane = tid & 63, r32 = lane & 31, hi = lane >> 5;
  bf16* V_lds = (bf16*)lds; bf16* K_lds = (bf16*)(lds + 2 * SHM_V);
  float* ws = (float*)(lds + LDS_WS) + wid * 64; float* li_l = ws; float* al_l = ws + 32;
  float m_reg = -1e30f, l_reg = 0.f; f32x16 o[4] = {}; bf16x8 qr[8];
  const bf16* Qw = U.Q + (long)(wid * QBLK + r32) * U.ldq + hi * 8;
#pragma unroll
  for (int d0 = 0; d0 < 8; ++d0) qr[d0] = *reinterpret_cast<const bf16x8*>(Qw + d0 * 16);
  if (U.qg) {
    float x[8][8]; float ss = 0.f;
#pragma unroll
    for (int d0 = 0; d0 < 8; ++d0) { const u32x4 w = *reinterpret_cast<const u32x4*>(&qr[d0]);
#pragma unroll
      for (int k = 0; k < 4; ++k) { x[d0][2 * k] = __uint_as_float(w[k] << 16); x[d0][2 * k + 1] = __uint_as_float(w[k] & 0xffff0000u); ss += x[d0][2 * k] * x[d0][2 * k] + x[d0][2 * k + 1] * x[d0][2 * k + 1]; } }
    ss += __shfl_xor(ss, 32);
    const float rms = 1.0f / sqrtf(ss * (1.0f / 128.0f) + 1e-6f);
#pragma unroll
    for (int d0 = 0; d0 < 8; ++d0) { const float* gp = U.qg + d0 * 16 + hi * 8; const f32x4g ga = *reinterpret_cast<const f32x4g*>(gp), gb = *reinterpret_cast<const f32x4g*>(gp + 4);
#pragma unroll
      for (int k = 0; k < 4; ++k) { x[d0][k] *= rms * ga[k]; x[d0][4 + k] *= rms * gb[k]; } }
    if (U.rope) { const float* rp = U.rope + ((long)(U.t0 + wid * QBLK + r32) * 64 + hi * 8) * 2;
#pragma unroll
      for (int d0 = 0; d0 < 4; ++d0)
#pragma unroll
        for (int k2 = 0; k2 < 4; ++k2) { const f32x4g cs = *reinterpret_cast<const f32x4g*>(rp + (d0 * 16 + 2 * k2) * 2);
          { const float a = x[d0][2 * k2], b = x[d0 + 4][2 * k2]; x[d0][2 * k2] = a * cs[0] - b * cs[1]; x[d0 + 4][2 * k2] = b * cs[0] + a * cs[1]; }
          { const float a = x[d0][2 * k2 + 1], b = x[d0 + 4][2 * k2 + 1]; x[d0][2 * k2 + 1] = a * cs[2] - b * cs[3]; x[d0 + 4][2 * k2 + 1] = b * cs[2] + a * cs[3]; } } }
#pragma unroll
    for (int d0 = 0; d0 < 8; ++d0) { u32x4 w = {cvtpk(x[d0][0], x[d0][1]), cvtpk(x[d0][2], x[d0][3]), cvtpk(x[d0][4], x[d0][5]), cvtpk(x[d0][6], x[d0][7])}; qr[d0] = *reinterpret_cast<bf16x8*>(&w); }
  }
  const int sr = tid >> 4, sc = (tid & 15) * 8, vst0 = v_st(sr, sc), vst1 = v_st(32 + sr, sc);
  const int vb0 = (int)(uintptr_t)V_lds + v_rd_base(lane);
  struct { bf16x8 vs0, vs1, ks0, ks1; } sr_[2];
#define D_SLOAD(i, k0) do { sr_[i].vs0 = *reinterpret_cast<const bf16x8*>(U.V + (long)((k0) + sr) * U.ldk + sc); sr_[i].vs1 = *reinterpret_cast<const bf16x8*>(U.V + (long)((k0) + 32 + sr) * U.ldk + sc); \
    sr_[i].ks0 = *reinterpret_cast<const bf16x8*>(U.K + (long)((k0) + sr) * U.ldk + sc); sr_[i].ks1 = *reinterpret_cast<const bf16x8*>(U.K + (long)((k0) + 32 + sr) * U.ldk + sc); } while (0)
#define D_SWRITE(b, i) do { *(bf16x8*)((char*)V_lds + (b) * SHM_V + vst0) = sr_[i].vs0; *(bf16x8*)((char*)V_lds + (b) * SHM_V + vst1) = sr_[i].vs1; const int kc_ = sc * 2; \
    *(bf16x8*)((char*)K_lds + (b) * SHM_K + KSWZ(sr, kc_)) = sr_[i].ks0; *(bf16x8*)((char*)K_lds + (b) * SHM_K + KSWZ(32 + sr, kc_)) = sr_[i].ks1; } while (0)
#define D_SWAIT() asm volatile("s_waitcnt vmcnt(4)" ::: "memory")
#define D_RESC(a) do { if (__any((a) < 1.f)) { if (hi == 0) al_l[r32] = (a); asm volatile("s_waitcnt lgkmcnt(0)" ::: "memory"); \
    _Pragma("unroll") for (int d = 0; d < 4; ++d) _Pragma("unroll") for (int r = 0; r < 16; ++r) o[d][r] *= al_l[crow(r, hi)]; } } while (0)
  f32x16 pA0, pA1, pB0, pB1; float mnA, mnB, alA, alB; bf16x8 pa0, pa1, pa2, pa3; const int NT = U.ntiles;
  constexpr int SE = 0, SO = 1;
  D_SLOAD(SE, 0); asm volatile("s_waitcnt vmcnt(0)" ::: "memory"); D_SWRITE(0, SE); __syncthreads();
  qkt(pA0, pA1, K_lds, qr, r32, hi); partialSM(pA0, pA1, m_reg, mnA, alA);
  D_SLOAD(SO, KVBLK); if (2 < NT) D_SLOAD(SE, 2 * KVBLK);
  D_SWAIT(); D_SWRITE(1, SO); __syncthreads();
  for (int j = 1; j + 1 < NT; j += 2) {
    SBAR(); qkt(pB0, pB1, (const bf16*)((const char*)K_lds + SHM_K), qr, r32, hi);
    finishSM(pA0, pA1, alA, l_reg, pa0, pa1, pa2, pa3); SBAR();
    D_SLOAD(SO, (j + 2) * KVBLK); SBAR();
    pv_d0(o, vb0, pa0, pa1, pa2, pa3); partialSM(pB0, pB1, m_reg, mnB, alB);
    __syncthreads(); D_SWAIT(); D_SWRITE(0, SE);
    D_RESC(alB); __syncthreads();
    SBAR(); qkt(pA0, pA1, K_lds, qr, r32, hi);
    finishSM(pB0, pB1, alB, l_reg, pa0, pa1, pa2, pa3); SBAR();
    if (j + 3 < NT) D_SLOAD(SE, (j + 3) * KVBLK); SBAR();
    pv_d0(o, vb0 + (int)SHM_V, pa0, pa1, pa2, pa3); partialSM(pA0, pA1, m_reg, mnA, alA);
    __syncthreads(); D_SWAIT(); D_SWRITE(1, SO);
    D_RESC(alA); __syncthreads();
  }
  SBAR(); qkt(pB0, pB1, (const bf16*)((const char*)K_lds + SHM_K), qr, r32, hi);
  finishSM(pA0, pA1, alA, l_reg, pa0, pa1, pa2, pa3); SBAR();
  pv_d0(o, vb0, pa0, pa1, pa2, pa3); partialSM(pB0, pB1, m_reg, mnB, alB);
  __syncthreads(); D_RESC(alB);
  finishSM(pB0, pB1, alB, l_reg, pa0, pa1, pa2, pa3); SBAR();
  pv_d0(o, vb0 + (int)SHM_V, pa0, pa1, pa2, pa3);
  if (hi == 0) li_l[r32] = l_reg; asm volatile("s_waitcnt lgkmcnt(0)" ::: "memory");
  float rli[16];
#pragma unroll
  for (int r = 0; r < 16; ++r) rli[r] = __builtin_amdgcn_rcpf(li_l[crow(r, hi)]);
  bf16* Ow = U.O + (long)(wid * QBLK) * U.ldo;
#pragma unroll
  for (int r = 0; r < 16; ++r) { const int orow = crow(r, hi);
#pragma unroll
    for (int d0 = 0; d0 < 4; ++d0) Ow[(long)orow * U.ldo + d0 * 32 + r32] = f2bf1(o[d0][r] * rli[r]); }
  __syncthreads();
#undef D_SLOAD
#undef D_SWRITE
#undef D_SWAIT
#undef D_RESC
}

__device__ __forceinline__ void attn_unit(const AUnit& U, char* lds) {
  int tid = threadIdx.x; asm volatile("" : "+v"(tid));
  const int wid = __builtin_amdgcn_readfirstlane(tid >> 6), lane = tid & 63, r32 = lane & 31, hi = lane >> 5;
  bf16* V_lds = (bf16*)lds; bf16* K_lds = (bf16*)(lds + 2 * SHM_V);
  float* ws = (float*)(lds + LDS_WS) + wid * 64; float* li_l = ws; float* al_l = ws + 32;
  float* rpbL = (float*)(lds + LDS_RPB);
  const int nband = U.nband, nt = U.ntiles;
  if (nband > 0 && tid < 465) rpbL[tid] = U.rpb[tid] * (1.0f / SCALE);
  float m_reg = -1e30f, l_reg = 0.f; f32x16 o[4] = {}; bf16x8 qr[8];
  const bf16* Qw = U.Q + (long)(wid * QBLK + r32) * U.ldq + hi * 8;
#pragma unroll
  for (int d0 = 0; d0 < 8; ++d0) qr[d0] = *reinterpret_cast<const bf16x8*>(Qw + d0 * 16);
  if (U.qg) {
    float x[8][8]; float ss = 0.f;
#pragma unroll
    for (int d0 = 0; d0 < 8; ++d0) { const u32x4 w = *reinterpret_cast<const u32x4*>(&qr[d0]);
#pragma unroll
      for (int k = 0; k < 4; ++k) { x[d0][2 * k] = __uint_as_float(w[k] << 16); x[d0][2 * k + 1] = __uint_as_float(w[k] & 0xffff0000u); ss += x[d0][2 * k] * x[d0][2 * k] + x[d0][2 * k + 1] * x[d0][2 * k + 1]; } }
    ss += __shfl_xor(ss, 32);
    const float rms = 1.0f / sqrtf(ss * (1.0f / 128.0f) + 1e-6f);
#pragma unroll
    for (int d0 = 0; d0 < 8; ++d0) { const float* gp = U.qg + d0 * 16 + hi * 8; const f32x4g ga = *reinterpret_cast<const f32x4g*>(gp), gb = *reinterpret_cast<const f32x4g*>(gp + 4);
#pragma unroll
      for (int k = 0; k < 4; ++k) { x[d0][k] *= rms * ga[k]; x[d0][4 + k] *= rms * gb[k]; } }
    if (U.rope) { const float* rp = U.rope + ((long)(U.t0 + wid * QBLK + r32) * 64 + hi * 8) * 2;
#pragma unroll
      for (int d0 = 0; d0 < 4; ++d0)
#pragma unroll
        for (int k2 = 0; k2 < 4; ++k2) { const f32x4g cs = *reinterpret_cast<const f32x4g*>(rp + (d0 * 16 + 2 * k2) * 2);
          { const float a = x[d0][2 * k2], b = x[d0 + 4][2 * k2]; x[d0][2 * k2] = a * cs[0] - b * cs[1]; x[d0 + 4][2 * k2] = b * cs[0] + a * cs[1]; }
          { const float a = x[d0][2 * k2 + 1], b = x[d0 + 4][2 * k2 + 1]; x[d0][2 * k2 + 1] = a * cs[2] - b * cs[3]; x[d0 + 4][2 * k2 + 1] = b * cs[2] + a * cs[3]; } } }
#pragma unroll
    for (int d0 = 0; d0 < 8; ++d0) { u32x4 w = {cvtpk(x[d0][0], x[d0][1]), cvtpk(x[d0][2], x[d0][3]), cvtpk(x[d0][4], x[d0][5]), cvtpk(x[d0][6], x[d0][7])}; qr[d0] = *reinterpret_cast<bf16x8*>(&w); }
  }
  const int sr = tid >> 4, sc = (tid & 15) * 8, vst0 = v_st(sr, sc), vst1 = v_st(32 + sr, sc);
  const int vb0 = (int)(uintptr_t)V_lds + v_rd_base(lane);
  const int gr = U.qrow0 + (wid >> 1), qc = (wid & 1) * 32 + r32;
  const int rstart = min(max(gr - 4, 0), 24), cs = min(max(qc - 8, 0), 48);
  bf16x8 vs0, vs1, ks0, ks1;
#define A_KBASE(j) (((j) < nband) ? (U.band0 + (j)) * KVBLK : U.ctx0 + ((j) - nband) * KVBLK)
#define A_SLOAD(k0) do { vs0 = *reinterpret_cast<const bf16x8*>(U.V + (long)((k0) + sr) * U.ldk + sc); vs1 = *reinterpret_cast<const bf16x8*>(U.V + (long)((k0) + 32 + sr) * U.ldk + sc); \
    ks0 = *reinterpret_cast<const bf16x8*>(U.K + (long)((k0) + sr) * U.ldk + sc); ks1 = *reinterpret_cast<const bf16x8*>(U.K + (long)((k0) + 32 + sr) * U.ldk + sc); } while (0)
#define A_SWRITE(b) do { *(bf16x8*)((char*)V_lds + (b) * SHM_V + vst0) = vs0; *(bf16x8*)((char*)V_lds + (b) * SHM_V + vst1) = vs1; const int kc_ = sc * 2; \
    *(bf16x8*)((char*)K_lds + (b) * SHM_K + KSWZ(sr, kc_)) = ks0; *(bf16x8*)((char*)K_lds + (b) * SHM_K + KSWZ(32 + sr, kc_)) = ks1; } while (0)
  { const int k0 = A_KBASE(0); A_SLOAD(k0); }
  A_SWRITE(0); __syncthreads();
  for (int j = 0; j < nt; ++j) {
    const int buf = j & 1;
    if (j + 1 < nt) { const int k1 = A_KBASE(j + 1); A_SLOAD(k1); }
    bool active = true; int dr = 0; const bool band = j < nband;
    if (band) { const int krow = U.band0 + j; active = (krow >= rstart) && (krow < rstart + 8); dr = krow - gr; }
    if (active) {
      f32x16 p0, p1; float mn, alpha; bf16x8 pa0, pa1, pa2, pa3;
      SBAR(); qkt(p0, p1, (const bf16*)((const char*)K_lds + buf * SHM_K), qr, r32, hi);
      if (band) {
        const float* brow = rpbL + (dr + 7) * 31 + 15;
#pragma unroll
        for (int r = 0; r < 16; ++r) {
          const int kc0 = crow(r, hi), kc1 = kc0 + 32;
          { const bool ok = (kc0 >= cs) && (kc0 < cs + 16); const int dc = min(max(kc0 - qc, -15), 15); const float b = brow[dc]; p0[r] = ok ? p0[r] + b : -1e30f; }
          { const bool ok = (kc1 >= cs) && (kc1 < cs + 16); const int dc = min(max(kc1 - qc, -15), 15); const float b = brow[dc]; p1[r] = ok ? p1[r] + b : -1e30f; }
        }
      }
      partialSM(p0, p1, m_reg, mn, alpha);
      if (__any(alpha < 1.f)) { if (hi == 0) al_l[r32] = alpha; asm volatile("s_waitcnt lgkmcnt(0)" ::: "memory");
#pragma unroll
        for (int d = 0; d < 4; ++d)
#pragma unroll
          for (int r = 0; r < 16; ++r) o[d][r] *= al_l[crow(r, hi)]; }
      finishSM(p0, p1, alpha, l_reg, pa0, pa1, pa2, pa3); SBAR();
      pv_d0(o, vb0 + buf * (int)SHM_V, pa0, pa1, pa2, pa3);
    }
    if (j + 1 < nt) A_SWRITE(buf ^ 1);
    __syncthreads();
  }
  if (hi == 0) li_l[r32] = l_reg; asm volatile("s_waitcnt lgkmcnt(0)" ::: "memory");
  float rli[16];
#pragma unroll
  for (int r = 0; r < 16; ++r) rli[r] = __builtin_amdgcn_rcpf(li_l[crow(r, hi)]);
  bf16* Ow = U.O + (long)(wid * QBLK) * U.ldo;
#pragma unroll
  for (int r = 0; r < 16; ++r) { const int orow = crow(r, hi);
#pragma unroll
    for (int d0 = 0; d0 < 4; ++d0) Ow[(long)orow * U.ldo + d0 * 32 + r32] = f2bf1(o[d0][r] * rli[r]); }
#undef A_KBASE
#undef A_SLOAD
#undef A_SWRITE
}
}

constexpr size_t MiB = 1u << 20;
constexpr size_t WS_CTL = 0, CTL_ZERO_BYTES = 1 * MiB;
constexpr size_t WS_MOD = 1 * MiB;
constexpr size_t WS_ROPE = 2 * MiB;
constexpr size_t WS_POOLW = 3 * MiB;
constexpr size_t WS_WINAB = 4 * MiB;
constexpr size_t WS_WOUTAB = WS_WINAB + (size_t)2 * 3072 * 2048 * 2;
constexpr size_t WS_WINCD = WS_WOUTAB + (size_t)2 * 2048 * 2048 * 2;
constexpr size_t WS_WOUTCD = WS_WINCD + (size_t)2 * 6144 * 2048 * 2;
constexpr size_t WS_WGU = WS_WOUTCD + (size_t)2 * 2048 * 2048 * 2;
constexpr size_t WS_WDN = WS_WGU + (size_t)4 * NGU * 2048 * 2;
constexpr size_t WS_H = WS_WDN + (size_t)4 * 2048 * FFH * 2;
constexpr size_t WS_PROJ = WS_H + (size_t)MTOK * DM * 2;
constexpr size_t WS_MIX = WS_PROJ + (size_t)MTOK * CD_IN * 2;
constexpr size_t WS_Y = WS_MIX + (size_t)MTOK * DM * 2;
constexpr size_t WS_Y2 = WS_Y + (size_t)MTOK * DM * 4;
constexpr size_t WS_X = WS_Y2 + (size_t)MTOK * DM * 4;
constexpr size_t WS_KLAB = WS_X + (size_t)MTOK * DM * 4;
constexpr size_t WS_VLAB = WS_KLAB + (size_t)2 * 2 * LKV * 512 * 2;
constexpr size_t WS_KLCD = WS_VLAB + (size_t)2 * 2 * LKV * 512 * 2;
constexpr size_t WS_VLCD = WS_KLCD + (size_t)2 * 2 * LKV * 1536 * 2;
constexpr size_t WS_END = WS_VLCD + (size_t)2 * 2 * LKV * 1536 * 2;
static_assert(WS_WINAB % 256 == 0 && WS_H % 256 == 0 && WS_KLAB % 256 == 0 && WS_END % 256 == 0, "alignment");
constexpr int CW_BAR = 4096;
constexpr int CW_Q = 16384;
constexpr size_t O_Y = 0;
__host__ __device__ constexpr size_t out_k_off(int i) { return i == 0 ? 25165824u : i == 1 ? 33554432u : i == 2 ? 58720256u : 67108864u; }
__host__ __device__ constexpr size_t out_v_off(int i) { return i == 0 ? 29360128u : i == 1 ? 46137344u : i == 2 ? 62914560u : 79691776u; }
constexpr size_t OUT_TOTAL = 92274688u;

constexpr int RING_OFF = 0, RING_BYTES = 131072;
constexpr int LDSCTL_OFF = RING_BYTES, MISC_OFF = LDSCTL_OFF + 320;
constexpr int LDS_BYTES = 147456;
static_assert(att::LDS_TOTAL <= RING_BYTES, "attention LDS fits the ring region");
constexpr int NWAVES = 8, NPHASES = 34;

#define GAS __attribute__((address_space(1)))
#define LAS __attribute__((address_space(3)))
typedef unsigned short bf16;
typedef unsigned v4u __attribute__((ext_vector_type(4)));
typedef float f32x4 __attribute__((ext_vector_type(4)));
typedef short bf16x8 __attribute__((ext_vector_type(8)));
typedef GAS unsigned gu32;
typedef GAS unsigned long long gu64;
#define RLX_AGENT __ATOMIC_RELAXED, __HIP_MEMORY_SCOPE_AGENT
#define LDS_WAIT() asm volatile("s_waitcnt lgkmcnt(0)" ::: "memory")
#define VM_WAIT() asm volatile("s_waitcnt vmcnt(0)" ::: "memory")
__device__ __forceinline__ unsigned long long rt() { return __builtin_amdgcn_s_memrealtime(); }
__device__ __forceinline__ unsigned f2bf(float f) { unsigned u = __builtin_bit_cast(unsigned, f); return (u + 0x7fffu + ((u >> 16) & 1u)) >> 16; }
__device__ __forceinline__ unsigned pk2(float lo, float hi) { return f2bf(lo) | (f2bf(hi) << 16); }

#define XB_TMO      128
#define XB_XCNT(j)  (256  + 64 * (j))
#define XB_XSUB(j)  (1280 + 64 * (j))
#define XB_XGEN(j)  (2304 + 64 * (j))
#define XB_TOP      3328
#define XB_TOPGEN   3392
#define XCD_BAR_WORDS 3456
#define XB_SPIN_CAP (1u << 18)

__device__ __forceinline__ unsigned xb_ld(unsigned* p)              { return __hip_atomic_load(p, __ATOMIC_RELAXED, __HIP_MEMORY_SCOPE_AGENT); }
__device__ __forceinline__ unsigned xb_add(unsigned* p, unsigned v) { return __hip_atomic_fetch_add(p, v, __ATOMIC_RELAXED, __HIP_MEMORY_SCOPE_AGENT); }
__device__ __forceinline__ unsigned xb_xcc_id() { return (unsigned)__builtin_amdgcn_s_getreg((3 << 11) | 20) & 0xFu; }
#define XB_SPIN(cond, bar) do { unsigned _sp = 0; while (cond) { __builtin_amdgcn_s_sleep(1); \
    if ((++_sp & 255u) == 0u) { if (xb_ld(&(bar)[XB_TMO])) break; if (_sp > XB_SPIN_CAP) { atomicAdd(&(bar)[XB_TMO], 1u); break; } } } } while (0)

struct XcdBarrier {
    unsigned* bar; unsigned x;
    volatile LAS unsigned* st;
};

__device__ __forceinline__ XcdBarrier xcd_barrier_post(unsigned* bar, volatile LAS unsigned* st) {
    XcdBarrier b; b.bar = bar; b.x = xb_xcc_id(); b.st = st;
    if (threadIdx.x == 0) (void)xb_add(&bar[XB_XCNT(b.x)], 1u);
    return b;
}
__device__ __forceinline__ void xcd_barrier_complete(unsigned* bar, unsigned x, unsigned& nloc, unsigned& nx) {
    const unsigned G = gridDim.x * gridDim.y * gridDim.z;
    unsigned sum, cnt, mine, sp = 0u;
    for (;;) {
        sum = 0u; cnt = 0u; mine = 0u;
#pragma unroll
        for (unsigned j = 0; j < 16; ++j) { const unsigned c = xb_ld(&bar[XB_XCNT(j)]); sum += c; cnt += (c > 0u) ? 1u : 0u; mine = (j == x) ? c : mine; }
        if (sum == G) break;
        __builtin_amdgcn_s_sleep(1);
        if ((++sp & 255u) == 0u) { if (xb_ld(&bar[XB_TMO])) break; if (sp > XB_SPIN_CAP) { atomicAdd(&bar[XB_TMO], 1u); break; } }
    }
    nloc = mine > 0u ? mine : 1u; nx = cnt > 0u ? cnt : 1u;
}

__device__ __forceinline__ void xcd_barrier(const XcdBarrier& b) {
    asm volatile("s_waitcnt vmcnt(0)" ::: "memory");
    __syncthreads();
    if (threadIdx.x == 0) {
        unsigned* bar = b.bar;
        __builtin_amdgcn_s_waitcnt(0);
        unsigned nloc = b.st[0], nx = b.st[1];
        if (nloc == 0u) { xcd_barrier_complete(bar, b.x, nloc, nx); b.st[0] = nloc; b.st[1] = nx; }
        const unsigned old = xb_add(&bar[XB_XSUB(b.x)], 1u);
        const unsigned gen = old / nloc;
        if (old + 1u == (gen + 1u) * nloc) {
            __builtin_amdgcn_fence(__ATOMIC_RELEASE, "agent");
            asm volatile("s_waitcnt vmcnt(0)" ::: "memory");
            const unsigned og = xb_add(&bar[XB_TOP], 1u);
            const unsigned tg = og / nx;
            if (og + 1u == (tg + 1u) * nx) xb_add(&bar[XB_TOPGEN], 1u);
            else XB_SPIN(xb_ld(&bar[XB_TOPGEN]) == tg, bar);
            __builtin_amdgcn_fence(__ATOMIC_ACQUIRE, "agent");
            xb_add(&bar[XB_XGEN(b.x)], 1u);
            asm volatile("s_waitcnt vmcnt(0)" ::: "memory");
        } else {
            XB_SPIN(xb_ld(&bar[XB_XGEN(b.x)]) == gen, bar);
            __builtin_amdgcn_fence(__ATOMIC_ACQUIRE, "agent");
            asm volatile("s_waitcnt vmcnt(0)" ::: "memory");
        }
    }
    __syncthreads();
}

struct Args { const float* in[31]; float* out; unsigned char* ws; int ph_lo, ph_hi; };
struct Frame {
    LAS unsigned char* lds; char* ldsg;
    volatile LAS unsigned* MISC;
    gu32* ctl;
    int vcu, G;
};
__device__ __forceinline__ int otid() { int t = threadIdx.x; asm volatile("" : "+v"(t)); return t; }
#define LANE_VARS const int tid_ = otid(), lane_ = tid_ & 63, wave_ = __builtin_amdgcn_readfirstlane(tid_ >> 6)

__device__ __forceinline__ float wave_sum(float v) {
#pragma unroll
    for (int o = 1; o < 64; o <<= 1) v += __shfl_xor(v, o);
    return v;
}
__device__ __forceinline__ float bf2f(unsigned short b) { return __builtin_bit_cast(float, (unsigned)b << 16); }
__device__ __forceinline__ float bflo(unsigned w) { return __builtin_bit_cast(float, w << 16); }
__device__ __forceinline__ float bfhi(unsigned w) { return __builtin_bit_cast(float, w & 0xffff0000u); }
__device__ __forceinline__ unsigned pkbf(float lo, float hi) { return pg8::cvt_pk_bf16(lo, hi); }
typedef unsigned u32x2v __attribute__((ext_vector_type(2)));
typedef float f32x16 __attribute__((ext_vector_type(16)));
__device__ __forceinline__ void unpack8(const v4u& w, float (&x)[8]) { x[0] = bflo(w.x); x[1] = bfhi(w.x); x[2] = bflo(w.y); x[3] = bfhi(w.y); x[4] = bflo(w.z); x[5] = bfhi(w.z); x[6] = bflo(w.w); x[7] = bfhi(w.w); }
__device__ __forceinline__ v4u pack8(const float (&x)[8]) { v4u w; w.x = pkbf(x[0], x[1]); w.y = pkbf(x[2], x[3]); w.z = pkbf(x[4], x[5]); w.w = pkbf(x[6], x[7]); return w; }

__device__ __forceinline__ void transpose_item(const float* W, int K, int N, bf16* WT, int mode, LAS float* scr, int item, int lane) {
    const int nblk = N / 64, kb = item / nblk, nb = item % nblk, k0 = 64 * kb, n0 = 64 * nb;
    int rb = n0; if (mode) rb = (n0 >> 7) * 256 + (n0 & 127) + (mode == 2 ? 128 : 0);
    float tv[64];
    const float* p = W + (size_t)k0 * N + n0 + lane;
#pragma unroll
    for (int i = 0; i < 64; ++i) tv[i] = __builtin_nontemporal_load(p + (size_t)i * N);
    const int c = lane & 7;
#pragma unroll
    for (int h = 0; h < 2; ++h) {
        if ((lane >> 5) == h) {
#pragma unroll
            for (int i = 0; i < 64; ++i) scr[i * 33 + (lane & 31)] = tv[i]; }
        LDS_WAIT(); asm volatile("" ::: "memory");
#pragma unroll
        for (int j = 0; j < 4; ++j) { const int n = (lane >> 3) + 8 * j; const LAS float* s = scr + (8 * c) * 33 + n;
            v4u o; o.x = pkbf(s[0 * 33], s[1 * 33]); o.y = pkbf(s[2 * 33], s[3 * 33]); o.z = pkbf(s[4 * 33], s[5 * 33]); o.w = pkbf(s[6 * 33], s[7 * 33]);
            *(GAS v4u*)(WT + (size_t)(rb + 32 * h + n) * K + k0 + 8 * c) = o; }
        LDS_WAIT(); asm volatile("" ::: "memory");
    }
}

template <int L> struct ConvMap {
    static constexpr bool even = !(L & 1); static constexpr int j = L >> 1;
    static constexpr int I_IN = even ? 32 * 48 : 32 * 96, I_OUT = 32 * 32, I_GU = 32 * 88, I_DN = 88 * 32, NI = I_IN + I_OUT + 2 * I_GU + I_DN;
};
template <int L>
__device__ __forceinline__ void convert_items(const Args& A, int it0, int it1, int gw, int ngw, LAS float* scr, int lane) {
    using CM = ConvMap<L>; constexpr int j = CM::j; unsigned char* ws = A.ws;
    for (int it = it0 + gw; it < it1; it += ngw) {
        int r = it;
        if (r < CM::I_IN) {
            if (CM::even) transpose_item(A.in[18] + (size_t)j * 2048 * 3072, 2048, 3072, (bf16*)(ws + WS_WINAB) + (size_t)j * 3072 * 2048, 0, scr, r, lane);
            else transpose_item(A.in[24] + (size_t)j * 2048 * 6144, 2048, 6144, (bf16*)(ws + WS_WINCD) + (size_t)j * 6144 * 2048, 0, scr, r, lane);
            continue; }
        r -= CM::I_IN;
        if (r < CM::I_OUT) {
            if (CM::even) transpose_item(A.in[19] + (size_t)j * 2048 * 2048, 2048, 2048, (bf16*)(ws + WS_WOUTAB) + (size_t)j * 2048 * 2048, 0, scr, r, lane);
            else transpose_item(A.in[25] + (size_t)j * 2048 * 2048, 2048, 2048, (bf16*)(ws + WS_WOUTCD) + (size_t)j * 2048 * 2048, 0, scr, r, lane);
            continue; }
        r -= CM::I_OUT;
        if (r < CM::I_GU) { transpose_item(A.in[28] + (size_t)L * 2048 * FFH, 2048, FFH, (bf16*)(ws + WS_WGU) + (size_t)L * NGU * 2048, 1, scr, r, lane); continue; } r -= CM::I_GU;
        if (r < CM::I_GU) { transpose_item(A.in[29] + (size_t)L * 2048 * FFH, 2048, FFH, (bf16*)(ws + WS_WGU) + (size_t)L * NGU * 2048, 2, scr, r, lane); continue; } r -= CM::I_GU;
        transpose_item(A.in[30] + (size_t)L * FFH * 2048, FFH, 2048, (bf16*)(ws + WS_WDN) + (size_t)L * 2048 * FFH, 0, scr, r, lane);
    }
}
template <int L>
__device__ __forceinline__ void ada_items(Frame& F, const Args& A, int first, int stride) {
    LANE_VARS;
    LAS float* S = (LAS float*)(F.lds);
    LAS f32x4* red = (LAS f32x4*)(F.lds + 24576);
    const float* c_lat = A.in[10]; const float* c_ctx = A.in[11]; const float* w_ada = A.in[12] + (size_t)L * 2048 * 12288; const float* b_ada = A.in[13] + (size_t)L * 12288;
    float* MOD = (float*)(A.ws + WS_MOD) + (size_t)L * 3 * 12288;
    if (first < 192) {
        for (int e = tid_; e < 3 * 2048; e += NWAVES * 64) { const int c = e >> 11, k = e & 2047; const float v = (c == 0) ? c_ctx[k] : c_lat[(c - 1) * 2048 + k]; S[e] = v / (1.0f + __expf(-v)); }
    }
    for (int it = first; it < 192; it += stride) {
        __syncthreads();
        const int cg = lane_ & 15, ks = lane_ >> 4, n = it * 64 + 4 * cg;
        const float* wp = w_ada + (size_t)(256 * wave_ + ks) * 12288 + n;
        f32x4 a0 = {0.f, 0.f, 0.f, 0.f}, a1 = a0, a2 = a0;
#pragma unroll 16
        for (int i = 0; i < 64; ++i) { const f32x4 w4 = __builtin_nontemporal_load((const f32x4*)(wp + (size_t)(4 * i) * 12288)); const int kk = 256 * wave_ + 4 * i + ks;
            a0 += w4 * S[kk]; a1 += w4 * S[2048 + kk]; a2 += w4 * S[4096 + kk]; }
#pragma unroll
        for (int e = 0; e < 4; ++e) { a0[e] += __shfl_xor(a0[e], 16); a0[e] += __shfl_xor(a0[e], 32); a1[e] += __shfl_xor(a1[e], 16); a1[e] += __shfl_xor(a1[e], 32); a2[e] += __shfl_xor(a2[e], 16); a2[e] += __shfl_xor(a2[e], 32); }
        if (lane_ < 16) { red[(wave_ * 3 + 0) * 16 + lane_] = a0; red[(wave_ * 3 + 1) * 16 + lane_] = a1; red[(wave_ * 3 + 2) * 16 + lane_] = a2; }
        __syncthreads();
        if (tid_ < 48) { const int c = tid_ >> 4, l = tid_ & 15; f32x4 s = red[(0 * 3 + c) * 16 + l];
#pragma unroll
            for (int w = 1; w < 8; ++w) s += red[(w * 3 + c) * 16 + l];
            const int nn = it * 64 + 4 * l; s += *(const f32x4*)(b_ada + nn);
            *(f32x4*)(MOD + (size_t)c * 12288 + nn) = s; }
    }
    __syncthreads();
}
#ifndef SIDE_MODE
#define SIDE_MODE 0
#endif
template <int L, int PART>
__device__ __forceinline__ void side_items(Frame& F, const Args& A, int ada_first, int ada_stride, int frac_lo, int frac_hi  , int m, int nm) {
    constexpr int NI = ConvMap<L>::NI;
    constexpr int B0 = (L & 1) ? 3690 : 1520, B1 = B0 + ((L & 1) ? 4380 : 4694);
    constexpr int it0 = PART == 0 ? 0 : (PART == 1 ? B0 : B1), it1 = PART == 0 ? B0 : (PART == 1 ? B1 : NI), n = it1 - it0;
    if (PART == 0) ada_items<L>(F, A, ada_first, ada_stride);
    LANE_VARS;
    convert_items<L>(A, it0 + (n * frac_lo) / 10, it0 + (n * frac_hi) / 10, m * NWAVES + wave_, nm * NWAVES, (LAS float*)(F.lds + wave_ * 8448), lane_);
    __syncthreads();
}
template <int L, int PART>
__device__ __forceinline__ void prefix_work(Frame& F, const Args& A, int nwg) {
    const int G = F.G, rounds = (nwg + G - 1) / G, busy_last = nwg - (rounds - 1) * G, c = (int)blockIdx.x;
    if (busy_last >= G || ((G - busy_last) & 31)) { side_items<L, PART>(F, A, c, G, 0, 10, c, G); return; }
    if (c < busy_last) return;
    const int k = c - busy_last, nidle = G - busy_last, g = (k >> 3) & 3, m = ((k >> 5) << 3) | (k & 7), nm = nidle >> 2;
    const int lo = g == 0 ? 0 : (g == 1 ? 1 : (g == 2 ? 3 : 6)), hi = g == 0 ? 1 : (g == 1 ? 3 : (g == 2 ? 6 : 10));
    side_items<L, PART>(F, A, k, nidle, lo, hi, m, nm);
}
__device__ __forceinline__ bool split_roles(const Frame& F, int nwg, bool has_side, int& geff, int& c, int& n) {
    const int G = F.G, bx = (int)blockIdx.x;
    geff = G; c = bx; n = 0;
    if (SIDE_MODE == 1 || !has_side || (G & 7)) return true;
    const int rounds = (nwg + G - 1) / G; int need = (nwg + rounds - 1) / rounds; need = (need + 7) & ~7;
    if (need >= G) return true;
    geff = need; n = G - need;
    const int xcd = bx & 7, idx = bx >> 3, per = need >> 3;
    if (idx < per) { c = idx * 8 + xcd; return true; }
    c = (idx - per) * 8 + xcd; return false;
}
template <int L, int PART>
__device__ __forceinline__ void side_work(Frame& F, const Args& A, int k, int n) { side_items<L, PART>(F, A, k, n, 0, 10, k, n); }

__device__ __forceinline__ void p0_prologue(Frame& F, const Args& A) {
    LANE_VARS;
    unsigned char* ws = A.ws;
    ada_items<0>(F, A, F.vcu, F.G);
    {
        constexpr int NI = ConvMap<0>::NI;
        int start, cnt;
        if (F.G == 256) { if (F.vcu < 192) { start = F.vcu * 40; cnt = 40; } else { start = 192 * 40 + (F.vcu - 192) * 52; cnt = 52; } }
        else { const int per = (NI + F.G - 1) / F.G; start = F.vcu * per; cnt = per; }
        int end = start + cnt; if (end > NI) end = NI;
        convert_items<0>(A, start, end, wave_, NWAVES, (LAS float*)(F.lds + wave_ * 8448), lane_);
    }
    const int gt = F.vcu * (NWAVES * 64) + tid_, NT = F.G * NWAVES * 64;
    {
        constexpr int C_AB = 2 * 256 * 512 / 8, C_CD = 2 * 256 * 1536 / 8;
        for (int idx = gt; idx < 4 * C_AB + 4 * C_CD; idx += NT) {
            const float* src; bf16* dst; int W, e;
            if (idx < 4 * C_AB) { const int tsr = idx / C_AB; e = (idx % C_AB) * 8; const int j = tsr >> 1, isv = tsr & 1; W = 512;
                src = j ? (isv ? A.in[7] : A.in[6]) : (isv ? A.in[3] : A.in[2]); dst = (bf16*)(ws + (isv ? WS_VLAB : WS_KLAB)) + (size_t)j * 2 * LKV * 512; }
            else { const int q = idx - 4 * C_AB; const int tsr = q / C_CD; e = (q % C_CD) * 8; const int j = tsr >> 1, isv = tsr & 1; W = 1536;
                src = j ? (isv ? A.in[9] : A.in[8]) : (isv ? A.in[5] : A.in[4]); dst = (bf16*)(ws + (isv ? WS_VLCD : WS_KLCD)) + (size_t)j * 2 * LKV * 1536; }
            const int b = e / (256 * W), rem = e % (256 * W), p = rem / W, c = rem % W;
            const f32x4 x0 = *(const f32x4*)(src + e), x1 = *(const f32x4*)(src + e + 4);
            v4u o; o.x = pkbf(x0[0], x0[1]); o.y = pkbf(x0[2], x0[3]); o.z = pkbf(x1[0], x1[1]); o.w = pkbf(x1[2], x1[3]);
            *(v4u*)(dst + ((size_t)(b * LKV + LSEQ + p)) * W + c) = o;
        }
    }
    {
        float* ROPE = (float*)(ws + WS_ROPE);
        for (int idx = gt; idx < 2048 * 64; idx += NT) { const int t = idx >> 6, i = idx & 63, fi = i & 31; const int pos = (i < 32) ? (t >> 6) : (t & 63);
            double inv = 1.0; for (int q = 0; q < fi; ++q) inv *= 0.74989420933245582;
            const double rev = (double)pos * inv * 0.15915494309189535; const float fr = (float)(rev - __builtin_rint(rev));
            ROPE[2 * idx] = __builtin_amdgcn_cosf(fr); ROPE[2 * idx + 1] = __builtin_amdgcn_sinf(fr); }
    }
    {
        bf16* PW = (bf16*)(ws + WS_POOLW); const float* pw = A.in[20];
        for (int idx = gt; idx < 2 * 4 * 128 * 128; idx += NT) { const int k = idx & 127, n = (idx >> 7) & 127, jg = idx >> 14;
            PW[idx] = (bf16)(pkbf(pw[((size_t)jg * 128 + k) * 128 + n], 0.f) & 0xffffu); }
    }
}

__device__ __forceinline__ void p1_modulate_x(Frame& F, const Args& A) {
    LANE_VARS;
    const int gw = F.vcu * NWAVES + wave_, NGW = F.G * NWAVES;
    const float* MOD = (const float*)(A.ws + WS_MOD); bf16* H = (bf16*)(A.ws + WS_H);
    for (int row = gw; row < MTOK; row += NGW) {
        const float* src = (row < NCTX) ? A.in[0] + (size_t)row * DM : A.in[1] + (size_t)(row - NCTX) * DM;
        const int cond = (row < NCTX) ? 0 : 1 + ((row - NCTX) >> 11);
        const f32x4* x4 = (const f32x4*)src + lane_; const f32x4* sh = (const f32x4*)(MOD + (size_t)cond * 12288) + lane_; const f32x4* sc = (const f32x4*)(MOD + (size_t)cond * 12288 + 2048) + lane_;
        u32x2v* o = (u32x2v*)(H + (size_t)row * DM) + lane_;
#pragma unroll
        for (int j = 0; j < 8; ++j) { const f32x4 v = x4[64 * j], s = sc[64 * j], h = sh[64 * j]; const f32x4 r = v * (s + 1.0f) + h;
            u32x2v w; w.x = pkbf(r[0], r[1]); w.y = pkbf(r[2], r[3]); o[64 * j] = w; }
    }
}

template <bool XIN_F32, bool XOUT_F32>
__device__ __forceinline__ void ln_phase(Frame& F, const void* XA, const void* XB  , const bf16* D, const bf16* D2  ,
                                         void* Xo, const float* lg, const float* lb, const float* mod_sh  , bf16* H) {
    LANE_VARS;
    const int gw = F.vcu * NWAVES + wave_, NGW = F.G * NWAVES;
    for (int row = gw; row < MTOK; row += NGW) {
        const u32x2v* d4 = (const u32x2v*)(D + (size_t)row * DM) + lane_;
        f32x4 v[8]; float s = 0.f;
#pragma unroll
        for (int j = 0; j < 8; ++j) {
            f32x4 x;
            if (XIN_F32) x = ((const f32x4*)((row < NCTX) ? (const float*)XA + (size_t)row * DM : (const float*)XB + (size_t)(row - NCTX) * DM) + lane_)[64 * j];
            else { const u32x2v xw = ((const u32x2v*)((row < NCTX) ? (const bf16*)XA + (size_t)row * DM : (const bf16*)XB + (size_t)(row - NCTX) * DM) + lane_)[64 * j]; x = (f32x4){bflo(xw.x), bfhi(xw.x), bflo(xw.y), bfhi(xw.y)}; }
            const u32x2v dw = d4[64 * j]; f32x4 dd = {bflo(dw.x), bfhi(dw.x), bflo(dw.y), bfhi(dw.y)};
            if (D2) { const u32x2v ew = ((const u32x2v*)(D2 + (size_t)row * DM) + lane_)[64 * j]; dd += (f32x4){bflo(ew.x), bfhi(ew.x), bflo(ew.y), bfhi(ew.y)}; }
            v[j] = x * ALPHA_RES + dd; s += (v[j][0] + v[j][1]) + (v[j][2] + v[j][3]); }
        const float mean = wave_sum(s) * (1.0f / DM); float q = 0.f;
#pragma unroll
        for (int j = 0; j < 8; ++j) { v[j] = v[j] - mean; q += (v[j][0] * v[j][0] + v[j][1] * v[j][1]) + (v[j][2] * v[j][2] + v[j][3] * v[j][3]); }
        const float rstd = 1.0f / sqrtf(wave_sum(q) * (1.0f / DM) + LN_EPS);
        const int cond = (row < NCTX) ? 0 : 1 + ((row - NCTX) >> 11);
        const f32x4* g4 = (const f32x4*)lg + lane_; const f32x4* b4 = (const f32x4*)lb + lane_;
        const float* msh = mod_sh ? mod_sh : lg;
        const f32x4* sh = (const f32x4*)(msh + (size_t)cond * 12288) + lane_; const f32x4* sc = (const f32x4*)(msh + (size_t)cond * 12288 + 2048) + lane_;
        u32x2v* o = (u32x2v*)(H + (size_t)row * DM) + lane_;
#pragma unroll
        for (int j = 0; j < 8; ++j) { const f32x4 x = v[j] * rstd * g4[64 * j] + b4[64 * j];
            if (XOUT_F32) ((f32x4*)((float*)Xo + (size_t)row * DM) + lane_)[64 * j] = x;
            else { u32x2v w; w.x = pkbf(x[0], x[1]); w.y = pkbf(x[2], x[3]); ((u32x2v*)((bf16*)Xo + (size_t)row * DM) + lane_)[64 * j] = w; }
            if (mod_sh) { const f32x4 r = x * (sc[64 * j] + 1.0f) + sh[64 * j]; u32x2v w; w.x = pkbf(r[0], r[1]); w.y = pkbf(r[2], r[3]); o[64 * j] = w; } }
    }
}

__device__ __forceinline__ void prep_ab(Frame& F, const Args& A, int layer, int j) {
    LANE_VARS;
    const int gw = F.vcu * NWAVES + wave_, NGW = F.G * NWAVES;
    bf16* PROJ = (bf16*)(A.ws + WS_PROJ); const float* ROPE = (const float*)(A.ws + WS_ROPE);
    bf16* KL = (bf16*)(A.ws + WS_KLAB) + (size_t)j * 2 * LKV * 512;
    float* outk = A.out + out_k_off(layer);
    const int l16 = lane_ & 15, hg = lane_ >> 4;
    float kg[8];
    { const f32x4* k4 = (const f32x4*)(A.in[23] + j * 128 + l16 * 8); const f32x4 c = k4[0], d = k4[1];
#pragma unroll
      for (int e = 0; e < 4; ++e) { kg[e] = c[e]; kg[4 + e] = d[e]; } }
    for (int row = gw; row < MTOK; row += NGW) {
        bf16* p = PROJ + (size_t)row * AB_IN + 2048 + hg * 128 + l16 * 8;
        const bool lat = row >= NCTX; const int t = (row - NCTX) & 2047, lbt = (row - NCTX) >> 11;
        const v4u raw = *(const v4u*)p; float x[8]; unpack8(raw, x);
        float ss = 0.f;
#pragma unroll
        for (int e = 0; e < 8; ++e) ss += x[e] * x[e];
        ss += __shfl_xor(ss, 1); ss += __shfl_xor(ss, 2); ss += __shfl_xor(ss, 4); ss += __shfl_xor(ss, 8);
        const float rms = 1.0f / sqrtf(ss * (1.0f / 128.0f) + RMS_EPS);
#pragma unroll
        for (int e = 0; e < 8; ++e) x[e] = x[e] * rms * kg[e];
        if (lat) {
            const f32x4* cs4 = (const f32x4*)(ROPE + ((size_t)t * 64 + (l16 & 7) * 8) * 2);
#pragma unroll
            for (int e2 = 0; e2 < 4; ++e2) { const f32x4 cs = cs4[e2];
                { const float pr = __shfl_xor(x[2 * e2], 8); x[2 * e2] = (l16 < 8) ? x[2 * e2] * cs[0] - pr * cs[1] : x[2 * e2] * cs[0] + pr * cs[1]; }
                { const float pr = __shfl_xor(x[2 * e2 + 1], 8); x[2 * e2 + 1] = (l16 < 8) ? x[2 * e2 + 1] * cs[2] - pr * cs[3] : x[2 * e2 + 1] * cs[2] + pr * cs[3]; } }
            *(v4u*)(KL + ((size_t)(lbt * LKV + t)) * 512 + hg * 128 + l16 * 8) = pack8(x);
        } else {
            *(v4u*)p = pack8(x); float* ok = outk + (size_t)row * 512 + hg * 128 + l16 * 8;
            *(f32x4*)ok = (f32x4){x[0], x[1], x[2], x[3]}; *(f32x4*)(ok + 4) = (f32x4){x[4], x[5], x[6], x[7]};
        }
    }
}

__device__ __forceinline__ void pool_unit(const Args& A, int j, int unit) {
    LANE_VARS;
    const int r32 = lane_ & 31, hi = lane_ >> 5;
    const bf16* PROJ = (const bf16*)(A.ws + WS_PROJ);
    const bf16* PW = (const bf16*)(A.ws + WS_POOLW) + (size_t)j * 4 * 128 * 128; const float* ps = A.in[21] + j * 512; bf16* MIX = (bf16*)(A.ws + WS_MIX);
    const int row = unit * 64 + (wave_ >> 2) * 32 + r32;
    int seq0, L, t; if (row < NCTX) { seq0 = row & ~255; L = 256; t = row & 255; } else { seq0 = NCTX + ((row - NCTX) & ~2047); L = 2048; t = (row - NCTX) & 2047; }
    { const int g = wave_ & 3;
        const int w = 2 << g;
        const int lo = max(t - w / 2, 0), hi_ = min(t - w / 2 + w - 1, L - 1); const float inv = 1.0f / (float)(hi_ - lo + 1);
        float s[8][8];
#pragma unroll
        for (int d0 = 0; d0 < 8; ++d0)
#pragma unroll
            for (int e = 0; e < 8; ++e) s[d0][e] = 0.f;
        const bf16* cbase = PROJ + g * 128 + hi * 8;
        for (int rr = lo; rr <= hi_; ++rr) { const bf16* pr = cbase + (size_t)(seq0 + rr) * AB_IN;
#pragma unroll
            for (int d0 = 0; d0 < 8; ++d0) { const v4u raw = *(const v4u*)(pr + d0 * 16); float x[8]; unpack8(raw, x);
#pragma unroll
                for (int e = 0; e < 8; ++e) s[d0][e] += x[e]; } }
        att::bf16x8 Bf[8];
        { const bf16* pr = cbase + (size_t)row * AB_IN;
#pragma unroll
          for (int d0 = 0; d0 < 8; ++d0) { const v4u raw = *(const v4u*)(pr + d0 * 16); float x[8]; unpack8(raw, x);
#pragma unroll
              for (int e = 0; e < 8; ++e) x[e] = s[d0][e] * inv - x[e];
              const v4u o = pack8(x); Bf[d0] = __builtin_bit_cast(att::bf16x8, o); } }
#pragma unroll
        for (int nb = 0; nb < 4; ++nb) {
            f32x16 acc = {};
            const bf16* wrow = PW + ((size_t)g * 128 + nb * 32 + r32) * 128 + hi * 8;
#pragma unroll
            for (int d0 = 0; d0 < 8; ++d0) { const att::bf16x8 a = *(const att::bf16x8*)(wrow + d0 * 16); acc = __builtin_amdgcn_mfma_f32_32x32x16_bf16(a, Bf[d0], acc, 0, 0, 0); }
#pragma unroll
            for (int q = 0; q < 4; ++q) { const int n0 = nb * 32 + 8 * q + 4 * hi; const f32x4 sc4 = *(const f32x4*)(ps + g * 128 + n0);
                u32x2v o; o.x = pkbf(acc[4 * q] * sc4[0], acc[4 * q + 1] * sc4[1]); o.y = pkbf(acc[4 * q + 2] * sc4[2], acc[4 * q + 3] * sc4[3]);
                *(u32x2v*)(MIX + (size_t)row * DM + g * 128 + n0) = o; }
        }
    }
}

__device__ __forceinline__ void conv_unit(const Args& A, int j, int unit) {
    LANE_VARS;
    const bf16* PROJ = (const bf16*)(A.ws + WS_PROJ); bf16* MIX = (bf16*)(A.ws + WS_MIX); const float* cw = A.in[27] + (size_t)j * 3 * 512;
    for (int idx = tid_; idx < 64 * 64; idx += NWAVES * 64) {
        const int row = unit * 64 + (idx >> 6), ch = (idx & 63) * 8;
        int L, t; if (row < NCTX) { L = 256; t = row & 255; } else { L = 2048; t = (row - NCTX) & 2047; }
        const bf16* pr = PROJ + (size_t)row * CD_IN + ch;
        float xi[8], gc[8], gb[8], u0[8], u1[8], u2[8];
        unpack8(*(const v4u*)(pr + 4608), xi); unpack8(*(const v4u*)(pr + 5632), gc); unpack8(*(const v4u*)(pr + 5120), gb);
#pragma unroll
        for (int e = 0; e < 8; ++e) u1[e] = gc[e] * xi[e];
        if (t > 0) { unpack8(*(const v4u*)(pr - CD_IN + 4608), xi); unpack8(*(const v4u*)(pr - CD_IN + 5632), gc);
#pragma unroll
            for (int e = 0; e < 8; ++e) u0[e] = gc[e] * xi[e]; }
        else {
#pragma unroll
            for (int e = 0; e < 8; ++e) u0[e] = 0.f; }
        if (t < L - 1) { unpack8(*(const v4u*)(pr + CD_IN + 4608), xi); unpack8(*(const v4u*)(pr + CD_IN + 5632), gc);
#pragma unroll
            for (int e = 0; e < 8; ++e) u2[e] = gc[e] * xi[e]; }
        else {
#pragma unroll
            for (int e = 0; e < 8; ++e) u2[e] = 0.f; }
        const f32x4 w0a = *(const f32x4*)(cw + ch), w0b = *(const f32x4*)(cw + ch + 4), w1a = *(const f32x4*)(cw + 512 + ch), w1b = *(const f32x4*)(cw + 512 + ch + 4), w2a = *(const f32x4*)(cw + 1024 + ch), w2b = *(const f32x4*)(cw + 1024 + ch + 4);
        float y[8];
#pragma unroll
        for (int e = 0; e < 4; ++e) { y[e] = gb[e] * (w0a[e] * u0[e] + w1a[e] * u1[e] + w2a[e] * u2[e]); y[4 + e] = gb[4 + e] * (w0b[e] * u0[4 + e] + w1b[e] * u1[4 + e] + w2b[e] * u2[4 + e]); }
        *(v4u*)(MIX + (size_t)row * DM + 1536 + ch) = pack8(y);
    }
}

__device__ __forceinline__ void attn_phase(Frame& F, const Args& A, int qslot, int layer, int j, bool even) {
    LANE_VARS;
    const bf16* PROJ = (const bf16*)(A.ws + WS_PROJ); bf16* MIX = (bf16*)(A.ws + WS_MIX);
    gu32* ctr = F.ctl + CW_Q + 64 * qslot;
    const int ldq = even ? AB_IN : CD_IN, qcol0 = even ? 512 : 0, kcol0 = even ? 2048 : 1536, vcol0 = even ? 2560 : 3072, mixcol0 = even ? 512 : 0, ldl = even ? 512 : 1536;
    const bf16* KL = even ? (const bf16*)(A.ws + WS_KLAB) + (size_t)j * 2 * LKV * 512 : (const bf16*)(A.ws + WS_KLCD) + (size_t)j * 2 * LKV * 1536;
    const bf16* VL = even ? (const bf16*)(A.ws + WS_VLAB) + (size_t)j * 2 * LKV * 512 : (const bf16*)(A.ws + WS_VLCD) + (size_t)j * 2 * LKV * 1536;
    const float* rpb = A.in[26] + (size_t)j * 12 * 465;
    const float* qgain = A.in[22] + j * 128; const float* ROPE = (const float*)(A.ws + WS_ROPE);
    constexpr int NLONG = 2 * 12 * 8, NATT = NLONG + 32 * 12, NUNITS = NATT + MTOK / 64;
    for (;;) {
        if (tid_ == 0) F.MISC[0] = __hip_atomic_fetch_add(ctr, 1u, __ATOMIC_RELAXED, __HIP_MEMORY_SCOPE_AGENT);
        __syncthreads();
        const int u = (int)F.MISC[0];
        __syncthreads();
        if (u >= NUNITS) break;
        if (u >= NATT) { if (even) pool_unit(A, j, u - NATT); else conv_unit(A, j, u - NATT); continue; }
        att::AUnit U; U.qg = even ? qgain : nullptr; U.rope = nullptr; U.t0 = 0;
        if (u < NLONG) {
            const int b = u / 96, rem = u % 96, h = rem >> 3, qb = rem & 7, kvh = even ? h / 3 : h;
            const size_t row0 = (size_t)NCTX + b * LSEQ + qb * 256;
            U.Q = PROJ + row0 * ldq + qcol0 + h * 128; U.ldq = ldq;
            U.K = KL + (size_t)b * LKV * ldl + kvh * 128; U.V = VL + (size_t)b * LKV * ldl + kvh * 128; U.ldk = ldl;
            U.O = MIX + row0 * DM + mixcol0 + h * 128; U.ldo = DM; U.rpb = rpb + h * 465;
            if (even) { U.ntiles = LKV / 64; U.nband = 0; U.band0 = 0; U.ctx0 = 0; U.qrow0 = 0; U.rope = ROPE; U.t0 = qb * 256; }
            else { const int b0 = min(max(4 * qb - 4, 0), 24), last = min(max(4 * qb - 1, 0), 24) + 7;
                U.nband = last - b0 + 1; U.band0 = b0; U.ctx0 = LSEQ; U.ntiles = U.nband + PAST / 64; U.qrow0 = 4 * qb; }
        } else {
            const int v = u - NLONG, b = v / 12, h = v % 12, kvh = even ? h / 3 : h;
            const size_t row0 = (size_t)b * 256;
            U.Q = PROJ + row0 * ldq + qcol0 + h * 128; U.ldq = ldq;
            U.K = PROJ + row0 * ldq + kcol0 + kvh * 128; U.V = PROJ + row0 * ldq + vcol0 + kvh * 128; U.ldk = ldq;
            U.O = MIX + row0 * DM + mixcol0 + h * 128; U.ldo = DM; U.rpb = rpb;
            U.ntiles = 4; U.nband = 0; U.band0 = 0; U.ctx0 = 0; U.qrow0 = 0;
        }
        if (U.nband == 0 && U.ntiles >= 8) att::attn_unit_dense(U, F.ldsg); else att::attn_unit(U, F.ldsg);
    }
}

#ifndef STAGGER_US
#define STAGGER_US 0
#endif
__device__ __forceinline__ void stagger_delay(int c) { if (STAGGER_US > 0 && ((c >> 3) & 1)) { const unsigned long long t0 = __builtin_amdgcn_s_memrealtime(); while (__builtin_amdgcn_s_memrealtime() - t0 < 100ull * STAGGER_US) __builtin_amdgcn_s_sleep(8); } }
#ifndef DOWN_KS
#define DOWN_KS 2
#endif
#ifndef PROBE_DUP
#define PROBE_DUP 0
#endif
#define NREP(mask) (((PROBE_DUP) & (mask)) ? 2 : 1)
#define IN(k) (lo <= (k) && (k) < hi)
#define SEAM(k) do { if (IN(k) && IN((k) + 1)) xcd_barrier(bar); } while (0)
template <int I>
__device__ __forceinline__ void run_layer(Frame& F, const Args& args, const XcdBarrier& bar, const int lo, const int hi) {
    constexpr int pb = 2 + 8 * I, j = I >> 1; constexpr bool even = !(I & 1);
    unsigned char* ws = args.ws;
    bf16* H = (bf16*)(ws + WS_H); bf16* PROJ = (bf16*)(ws + WS_PROJ); bf16* MIX = (bf16*)(ws + WS_MIX);
    bf16* D1 = (bf16*)(ws + WS_Y); bf16* D2 = (bf16*)(ws + WS_Y2); bf16* X = (bf16*)(ws + WS_X); float* MOD = (float*)(ws + WS_MOD);
    const float* modl = MOD + (size_t)I * 3 * 12288;
    if (IN(pb + 0)) {
        constexpr int N = even ? AB_IN : CD_IN;
        const bf16* Wt = even ? (const bf16*)(ws + WS_WINAB) + (size_t)j * AB_IN * DM : (const bf16*)(ws + WS_WINCD) + (size_t)j * CD_IN * DM;
        int geff, c, nside; const bool is_gemm = split_roles(F, (MTOK / 256) * (N / 256), I < 3, geff, c, nside);
        pg8::Gemm g{H, Wt, MTOK, N, DM, DM}; pg8::StaticOrder S; S.init(MTOK, N, geff, c);
        pg8::EpiProj E;
        E.O = PROJ; E.ldc = N;
        if (even) { E.lo = 2560; E.mid = 3072; E.hi = 3072; E.R0 = (bf16*)(ws + WS_VLAB) + (size_t)j * 2 * LKV * 512; E.R1 = E.R0; E.rld = 512; E.F0 = args.out + out_v_off(I); E.F1 = E.F0; }
        else { E.lo = 1536; E.mid = 3072; E.hi = 4608; E.R0 = (bf16*)(ws + WS_KLCD) + (size_t)j * 2 * LKV * 1536; E.R1 = (bf16*)(ws + WS_VLCD) + (size_t)j * 2 * LKV * 1536; E.rld = 1536;
            E.F0 = args.out + out_k_off(I); E.F1 = args.out + out_v_off(I); }
        if constexpr (I < 3 && SIDE_MODE == 1) prefix_work<I + 1, 0>(F, args, (MTOK / 256) * (N / 256));
        if (is_gemm) { stagger_delay(c); for (int rep = 0; rep < NREP(1); ++rep) pg8::gemm_phase<pg8::EpiProj, pg8::StaticOrder, true, true>(F.lds + RING_OFF, g, S, E); }
        if constexpr (I < 3 && SIDE_MODE == 0) { if (!is_gemm) side_work<I + 1, 0>(F, args, c, nside); else if (nside == 0) side_work<I + 1, 0>(F, args, c, geff); }
    }
    SEAM(pb + 0);
    if (even) { if (IN(pb + 1)) prep_ab(F, args, I, j); SEAM(pb + 1); }
    if (IN(pb + 2)) { for (int rep = 0; rep < NREP(2); ++rep) attn_phase(F, args, I + 4 * rep, I, j, even); }
    SEAM(pb + 2);
    if (IN(pb + 3)) {
        const bf16* Wt = even ? (const bf16*)(ws + WS_WOUTAB) + (size_t)j * DM * DM : (const bf16*)(ws + WS_WOUTCD) + (size_t)j * DM * DM;
        int geff, c, nside; const bool is_gemm = split_roles(F, (MTOK / 256) * (DM / 256), I < 3, geff, c, nside);
        pg8::Gemm g{MIX, Wt, MTOK, DM, DM, DM}; pg8::StaticOrder S; S.init(MTOK, DM, geff, c);
        pg8::EpiD E{D1, D1, modl + 4096};
        if constexpr (I < 3 && SIDE_MODE == 1) prefix_work<I + 1, 1>(F, args, (MTOK / 256) * (DM / 256));
        if (is_gemm) { stagger_delay(c); for (int rep = 0; rep < NREP(4); ++rep) pg8::gemm_phase<pg8::EpiD, pg8::StaticOrder, true, true>(F.lds + RING_OFF, g, S, E); }
        if constexpr (I < 3 && SIDE_MODE == 0) { if (!is_gemm) side_work<I + 1, 1>(F, args, c, nside); else if (nside == 0) side_work<I + 1, 1>(F, args, c, geff); }
    }
    SEAM(pb + 3);
    if (IN(pb + 4)) { for (int rep = 0; rep < NREP(16); ++rep) if (I == 0) ln_phase<true, false>(F, args.in[0], args.in[1], D1, nullptr, X, args.in[14] + I * DM, args.in[15] + I * DM, modl + 6144, H); else ln_phase<false, false>(F, X, X + (size_t)NCTX * DM, D1, nullptr, X, args.in[14] + I * DM, args.in[15] + I * DM, modl + 6144, H); }
    SEAM(pb + 4);
    if (IN(pb + 5)) {
        pg8::Gemm g{H, (const bf16*)(ws + WS_WGU) + (size_t)I * NGU * DM, MTOK, NGU, DM, DM};
        int geff, c, nside; const bool is_gemm = split_roles(F, (MTOK / 256) * (NGU / 256), I < 3, geff, c, nside); pg8::StaticOrder S; S.init(MTOK, NGU, geff, c);
        pg8::EpiGU E{PROJ};
        if constexpr (I < 3 && SIDE_MODE == 1) prefix_work<I + 1, 2>(F, args, (MTOK / 256) * (NGU / 256));
        if (is_gemm) { stagger_delay(c); for (int rep = 0; rep < NREP(8); ++rep) pg8::gemm_phase<pg8::EpiGU, pg8::StaticOrder, true, true>(F.lds + RING_OFF, g, S, E); }
        if constexpr (I < 3 && SIDE_MODE == 0) { if (!is_gemm) side_work<I + 1, 2>(F, args, c, nside); else if (nside == 0) side_work<I + 1, 2>(F, args, c, geff); }
    }
    SEAM(pb + 5);
    if (IN(pb + 6)) {
        pg8::Gemm g{PROJ, (const bf16*)(ws + WS_WDN) + (size_t)I * DM * FFH, MTOK, DM, FFH / DOWN_KS, FFH}; pg8::StaticOrder S; S.init(MTOK, DM, F.G, (int)blockIdx.x, DOWN_KS, FFH / DOWN_KS);
        pg8::EpiD E{D1, D2, modl + 10240};
        stagger_delay((int)blockIdx.x);
        for (int rep = 0; rep < NREP(4); ++rep) pg8::gemm_phase<pg8::EpiD, pg8::StaticOrder, true, true>(F.lds + RING_OFF, g, S, E);
    }
    SEAM(pb + 6);
    if (IN(pb + 7)) {
        if (I < 3) { for (int rep = 0; rep < NREP(16); ++rep) ln_phase<false, false>(F, X, X + (size_t)NCTX * DM, D1, DOWN_KS > 1 ? D2 : nullptr, X, args.in[16] + I * DM, args.in[17] + I * DM, modl + 3 * 12288, H); }
        else ln_phase<false, true>(F, X, X + (size_t)NCTX * DM, D1, DOWN_KS > 1 ? D2 : nullptr, args.out, args.in[16] + I * DM, args.in[17] + I * DM, nullptr, H);
    }
    if (I < 3) SEAM(pb + 7);
}

__global__ void __launch_bounds__(NWAVES * 64, 2) mk_fwd(Args args) {
    extern __shared__ __attribute__((aligned(16))) unsigned char lds[];
    Frame F;
    F.lds = (LAS unsigned char*)lds; F.ldsg = (char*)lds;
    F.MISC = (volatile LAS unsigned*)(F.lds + MISC_OFF);
    F.G = gridDim.x; { const int bx = blockIdx.x; F.vcu = (F.G % 8 == 0) ? (bx % 8) * (F.G / 8) + bx / 8 : bx; }
    F.ctl = (gu32*)(args.ws + WS_CTL);
    for (int u = threadIdx.x; u < (LDS_BYTES - LDSCTL_OFF) / 4; u += NWAVES * 64) ((LAS unsigned*)(F.lds + LDSCTL_OFF))[u] = 0u;
    __syncthreads();
    const int lo = args.ph_lo, hi = args.ph_hi;
    XcdBarrier bar; bar.bar = (unsigned*)(F.ctl + CW_BAR); bar.x = 0; bar.st = nullptr;
    if (hi - lo > 1) bar = xcd_barrier_post((unsigned*)(F.ctl + CW_BAR), F.MISC + 8);

    if (IN(0)) { for (int rep = 0; rep < NREP(32); ++rep) p0_prologue(F, args); }
    SEAM(0);
    if (IN(1)) { for (int rep = 0; rep < NREP(32); ++rep) p1_modulate_x(F, args); }
    SEAM(1);
    run_layer<0>(F, args, bar, lo, hi);
    run_layer<1>(F, args, bar, lo, hi);
    run_layer<2>(F, args, bar, lo, hi);
    run_layer<3>(F, args, bar, lo, hi);
}
#undef IN
#undef SEAM

extern "C" void kernel_launch(void* const* d_in, const int* in_sizes, int n_in, void* d_out, int out_size, void* d_ws, size_t ws_size, hipStream_t stream) {
    static int grid = 0;
    if (grid == 0) {
        if (n_in != 31 || (size_t)out_size != OUT_TOTAL || ws_size < WS_END) { fprintf(stderr, "kernel_launch: unexpected shapes: n_in %d out %d ws %zu (need %zu)\n", n_in, out_size, ws_size, (size_t)WS_END); grid = -1; return; }
        int dev = 0, cus = 0, per_cu = 0;
        if (hipGetDevice(&dev) != hipSuccess || hipDeviceGetAttribute(&cus, hipDeviceAttributeMultiprocessorCount, dev) != hipSuccess) { grid = -1; return; }
        if (hipFuncSetAttribute((const void*)mk_fwd, hipFuncAttributeMaxDynamicSharedMemorySize, LDS_BYTES) != hipSuccess) { fprintf(stderr, "kernel_launch: hipFuncSetAttribute failed\n"); grid = -1; return; }
        if (hipOccupancyMaxActiveBlocksPerMultiprocessor(&per_cu, (const void*)mk_fwd, NWAVES * 64, LDS_BYTES) != hipSuccess || per_cu < 1) fprintf(stderr, "kernel_launch: occupancy query reports %d\n", per_cu);
        (void)hipGetLastError();
        grid = cus;
    }
    if (grid < 0) return;
    if (hipMemsetAsync((char*)d_ws + WS_CTL, 0, CTL_ZERO_BYTES, stream) != hipSuccess) return;
    Args a{};
    for (int i = 0; i < 31; ++i) a.in[i] = (const float*)d_in[i];
    a.out = (float*)d_out; a.ws = (unsigned char*)d_ws;
#if MK_PER_PHASE
    for (int p = 0; p < NPHASES; ++p) { a.ph_lo = p; a.ph_hi = p + 1; hipLaunchKernelGGL(mk_fwd, dim3(grid), dim3(NWAVES * 64), LDS_BYTES, stream, a); }
#else
    a.ph_lo = 0; a.ph_hi = NPHASES; hipLaunchKernelGGL(mk_fwd, dim3(grid), dim3(NWAVES * 64), LDS_BYTES, stream, a);
#endif
    const hipError_t le = hipPeekAtLastError();
    if (le != hipSuccess) fprintf(stderr, "kernel_launch: launch failed: %s\n", hipGetErrorName(le));
}
```

```cpp
#include <hip/hip_runtime.h>
#include <cstdio>
#include <cstdint>

#ifndef MK_PER_PHASE
#define MK_PER_PHASE 0
#endif

constexpr int DM = 2048, NCTX = 8192, NLAT = 4096, MTOK = NCTX + NLAT, FFH = 5632, NGU = 2 * FFH;
constexpr int LSEQ = 2048, PAST = 256, LKV = LSEQ + PAST;
constexpr int AB_IN = 3072, CD_IN = 6144;
constexpr float ALPHA_RES = 1.6817928305074292f;
constexpr float LN_EPS = 1e-5f, RMS_EPS = 1e-6f;
namespace pg8 {
#define PG8_LAS __attribute__((address_space(3)))
typedef unsigned short bf16_t;
typedef short bf16x8 __attribute__((ext_vector_type(8)));
typedef float f32x4 __attribute__((ext_vector_type(4)));
typedef unsigned u32x4 __attribute__((ext_vector_type(4)));
constexpr int BM = 256, BK = 64, HALF = 128, HTB = HALF * BK * 2  , STAGE_BYTES = 8 * HTB, NXCD = 8, WGM = 8;

__host__ __device__ __forceinline__ int lds_byte(int r, int c) { const int st = (r >> 4) * 2 + (c >> 5), rr = r & 15, cc = c & 31, ob = rr * 64 + cc * 2; return st * 1024 + (ob ^ (((ob >> 9) & 1) << 5)); }
__host__ __device__ __forceinline__ void stage_rc(int b, int& R, int& C) { const int st = b / 1024, sb = b % 1024, swz = sb ^ (((sb >> 9) & 1) << 5); R = (st >> 1) * 16 + swz / 64; C = (st & 1) * 32 + (swz % 64) / 2; }
__host__ __device__ __forceinline__ int perm32(int rho) { const int n = rho >> 4, i = rho & 15; return 8 * (i >> 2) + 4 * n + (i & 3); }

struct Unit { int pm, pn, ko; };
struct Gemm { const bf16_t* A; const bf16_t* Bt; int M, N, K, ld; };

struct StaticOrder {
    int nM, nN, nwg, G, c, per, klen;
    __host__ __device__ void init(int M, int N, int G_, int c_, int ks_ = 1, int klen_ = 0) { nM = M / BM; nN = N / BM; per = nM * nN; nwg = per * ks_; G = G_; c = c_; klen = klen_; }
    __host__ __device__ bool next(int i, Unit& u) const {
        const long L = (long)i * G + c; if (L >= nwg) return false;
        int wgid = (int)L; { const int q = nwg / NXCD, r = nwg % NXCD, xcd = wgid % NXCD, off = wgid / NXCD; wgid = (xcd < r ? xcd * (q + 1) : r * (q + 1) + (xcd - r) * q) + off; }
        const int kh = wgid / per; wgid -= kh * per; u.ko = kh * klen;
        const int nig = WGM * nN, gid = wgid / nig, fm = gid * WGM, gsz = (nM - fm) < WGM ? (nM - fm) : WGM;
        u.pm = fm + ((wgid % nig) % gsz); u.pn = (wgid % nig) / gsz; return true;
    }
    __device__ __forceinline__ void a_ready(const Unit&) const {}
    __device__ __forceinline__ void done(const Unit&) const {}
};

__device__ __forceinline__ unsigned cvt_pk_bf16(float lo, float hi) { unsigned r; asm volatile("v_cvt_pk_bf16_f32 %0, %1, %2" : "=v"(r) : "v"(lo), "v"(hi)); return r; }
typedef float f32x2 __attribute__((ext_vector_type(2)));

#ifndef EPI_WT
#define EPI_WT 0
#endif
__device__ __forceinline__ void st16_wt(void* p, const u32x4& w) {
#if EPI_WT
    asm volatile("global_store_dwordx4 %0, %1, off sc1\n\ts_nop 0" :: "v"(p), "v"(w) : "memory");
#else
    *(u32x4*)p = w;
#endif
}
__device__ __forceinline__ int panel_cond(int pm) { return pm < 32 ? 0 : (pm < 40 ? 1 : 2); }

struct EpiProj {
    static constexpr bool PERM = true, AFTER_DRAIN = false;
    bf16_t* O; int ldc; int lo, mid, hi; bf16_t* R0; bf16_t* R1; int rld; float* F0; float* F1;
    __device__ __forceinline__ void operator()(const f32x4 (&acc)[2][2][4][2], const Unit& u, int wr, int wc, int fr, int fq) const {
        const int colt = u.pn * BM, cl = wc * 32 + 8 * fq, rl = wr * 64 + fr;
        const bool inr = colt >= lo && colt < hi; const int t = (colt >= mid) ? 1 : 0; const int cbase = colt - (t ? mid : lo);
        if (inr && u.pm >= 32) {
            bf16_t* R = t ? R1 : R0; const int lb = (u.pm - 32) >> 3, t0 = ((u.pm - 32) & 7) * 256;
            bf16_t* base = R + (size_t)(lb * 2304 + t0 + rl) * rld + cbase + cl;
#pragma unroll
            for (int ai = 0; ai < 2; ++ai)
#pragma unroll
                for (int m = 0; m < 4; ++m) { bf16_t* rowp = base + (size_t)(ai * HALF + m * 16) * rld;
#pragma unroll
                    for (int bj = 0; bj < 2; ++bj) { const f32x4 v0 = acc[ai][bj][m][0], v1 = acc[ai][bj][m][1];
                        u32x4 w; w.x = cvt_pk_bf16(v0[0], v0[1]); w.y = cvt_pk_bf16(v0[2], v0[3]); w.z = cvt_pk_bf16(v1[0], v1[1]); w.w = cvt_pk_bf16(v1[2], v1[3]);
                        st16_wt(rowp + bj * HALF, w); } }
        } else {
            bf16_t* base = O + (size_t)(u.pm * BM + rl) * ldc + colt + cl;
#pragma unroll
            for (int ai = 0; ai < 2; ++ai)
#pragma unroll
                for (int m = 0; m < 4; ++m) { bf16_t* rowp = base + (size_t)(ai * HALF + m * 16) * ldc;
#pragma unroll
                    for (int bj = 0; bj < 2; ++bj) { const f32x4 v0 = acc[ai][bj][m][0], v1 = acc[ai][bj][m][1];
                        u32x4 w; w.x = cvt_pk_bf16(v0[0], v0[1]); w.y = cvt_pk_bf16(v0[2], v0[3]); w.z = cvt_pk_bf16(v1[0], v1[1]); w.w = cvt_pk_bf16(v1[2], v1[3]);
                        st16_wt(rowp + bj * HALF, w); } }
            float* Fp = t ? F1 : F0;
            if (inr && Fp) {
                float* fb = Fp + (size_t)(u.pm * BM + rl) * rld + cbase + cl;
#pragma unroll
                for (int ai = 0; ai < 2; ++ai)
#pragma unroll
                    for (int m = 0; m < 4; ++m) { float* rowp = fb + (size_t)(ai * HALF + m * 16) * rld;
#pragma unroll
                        for (int bj = 0; bj < 2; ++bj) { *(f32x4*)(rowp + bj * HALF) = acc[ai][bj][m][0]; *(f32x4*)(rowp + bj * HALF + 4) = acc[ai][bj][m][1]; } }
            }
        }
    }
};

struct EpiD {
    static constexpr bool PERM = true, AFTER_DRAIN = false;
    bf16_t* D; bf16_t* D2; const float* gate;
    __device__ __forceinline__ void operator()(const f32x4 (&acc)[2][2][4][2], const Unit& u, int wr, int wc, int fr, int fq) const {
        const float* gv = gate + panel_cond(u.pm) * 12288 + u.pn * BM + wc * 32 + 8 * fq;
        bf16_t* base = (u.ko ? D2 : D) + (size_t)(u.pm * BM + wr * 64 + fr) * 2048 + u.pn * BM + wc * 32 + 8 * fq;
        f32x4 g4[2][2];
#pragma unroll
        for (int bj = 0; bj < 2; ++bj)
#pragma unroll
            for (int n = 0; n < 2; ++n) g4[bj][n] = *(const f32x4*)(gv + bj * HALF + 4 * n);
#pragma unroll
        for (int ai = 0; ai < 2; ++ai)
#pragma unroll
            for (int m = 0; m < 4; ++m) { bf16_t* rowp = base + (size_t)(ai * HALF + m * 16) * 2048;
#pragma unroll
                for (int bj = 0; bj < 2; ++bj) { const f32x4 v0 = acc[ai][bj][m][0] * g4[bj][0], v1 = acc[ai][bj][m][1] * g4[bj][1];
                    u32x4 w; w.x = cvt_pk_bf16(v0[0], v0[1]); w.y = cvt_pk_bf16(v0[2], v0[3]); w.z = cvt_pk_bf16(v1[0], v1[1]); w.w = cvt_pk_bf16(v1[2], v1[3]);
                    st16_wt(rowp + bj * HALF, w); } }
    }
};

struct EpiGU {
    static constexpr bool PERM = true, AFTER_DRAIN = false;
    bf16_t* ACT;
    static __device__ __forceinline__ float silu_mul(float g, float up) { const float e = __builtin_amdgcn_exp2f(g * -1.4426950408889634f); return g * __builtin_amdgcn_rcpf(1.0f + e) * up; }
    __device__ __forceinline__ void operator()(const f32x4 (&acc)[2][2][4][2], const Unit& u, int wr, int wc, int fr, int fq) const {
        bf16_t* base = ACT + (size_t)(u.pm * BM + wr * 64 + fr) * 5632 + u.pn * HALF + wc * 32 + 8 * fq;
#pragma unroll
        for (int ai = 0; ai < 2; ++ai)
#pragma unroll
            for (int m = 0; m < 4; ++m) { const f32x4 g0 = acc[ai][0][m][0], g1 = acc[ai][0][m][1], u0 = acc[ai][1][m][0], u1 = acc[ai][1][m][1];
                u32x4 w; w.x = cvt_pk_bf16(silu_mul(g0[0], u0[0]), silu_mul(g0[1], u0[1])); w.y = cvt_pk_bf16(silu_mul(g0[2], u0[2]), silu_mul(g0[3], u0[3]));
                w.z = cvt_pk_bf16(silu_mul(g1[0], u1[0]), silu_mul(g1[1], u1[1])); w.w = cvt_pk_bf16(silu_mul(g1[2], u1[2]), silu_mul(g1[3], u1[3]));
                st16_wt(base + (size_t)(ai * HALF + m * 16) * 5632, w); }
    }
};

template <class Epi, class Sched, bool ALIGN_EPI = false, bool SP2 = false>
__device__ __forceinline__ void gemm_phase(PG8_LAS unsigned char* lds, const Gemm g, const Sched& S, const Epi& E) {
    int tid = threadIdx.x; asm volatile("" : "+v"(tid));
    const int wid = __builtin_amdgcn_readfirstlane(tid >> 6), lane = tid & 63, wr = wid >> 2, wc = wid & 3, fr = lane & 15, fq = lane >> 4;
    const int K = g.K, LD = g.ld, nt = K / BK;
    unsigned voffA[2], voffB[2];
#pragma unroll
    for (int i = 0; i < 2; ++i) { int R, C; stage_rc(tid * 16 + i * 8192, R, C); const int Rb = Epi::PERM ? ((R & ~31) + perm32(R & 31)) : R;
        voffA[i] = (unsigned)(R * LD + C) * 2u; voffB[i] = (unsigned)(Rb * LD + C) * 2u; }
    const size_t kstep = (size_t)(BK * 2);
    const size_t hstep = (size_t)HALF * LD * 2;
    const size_t tstep = 2 * hstep;
    const unsigned ldsw = (unsigned)wid * 1024u;
    const int aoff = lds_byte(wr * 64 + fr, fq * 8), boff = lds_byte(wc * 32 + fr, fq * 8);
#define PG8_SA(b, h) (((b) * 2 + (h)) * HTB)
#define PG8_SB(b, h) ((4 + (b) * 2 + (h)) * HTB)
#define PG8_STAGE(bufoff, gbase, voff) do { _Pragma("unroll") for (int _i = 0; _i < 2; ++_i) \
        __builtin_amdgcn_global_load_lds((const unsigned*)((const char*)(gbase) + (voff)[_i]), (PG8_LAS unsigned*)(lds + (bufoff) + ldsw + _i * 8192), 16, 0, 0); } while (0)
#define PG8_LDA(dst, b, h) do { _Pragma("unroll") for (int m = 0; m < 4; ++m) _Pragma("unroll") for (int k = 0; k < 2; ++k) dst[m][k] = *(const PG8_LAS bf16x8*)(lds + PG8_SA(b, h) + aoff + m * 2048 + k * 1024); } while (0)
#define PG8_LDB(dst, b, h) do { _Pragma("unroll") for (int n = 0; n < 2; ++n) _Pragma("unroll") for (int k = 0; k < 2; ++k) dst[n][k] = *(const PG8_LAS bf16x8*)(lds + PG8_SB(b, h) + boff + n * 2048 + k * 1024); } while (0)
#define PG8_MMA(ai, bj, At, Bt) do { __builtin_amdgcn_s_setprio(1); _Pragma("unroll") for (int m = 0; m < 4; ++m) _Pragma("unroll") for (int n = 0; n < 2; ++n) _Pragma("unroll") for (int k = 0; k < 2; ++k) \
        acc[ai][bj][m][n] = __builtin_amdgcn_mfma_f32_16x16x32_bf16(Bt[n][k], At[m][k], acc[ai][bj][m][n], 0, 0, 0); __builtin_amdgcn_s_setprio(0); } while (0)
#define PG8_WAIT_V(n) asm volatile("s_waitcnt vmcnt(" #n ")" ::: "memory")
#define PG8_WAIT_L(n) asm volatile("s_waitcnt lgkmcnt(" #n ")" ::: "memory")
#define PG8_BAR __builtin_amdgcn_s_barrier()
#define PG8_SCHED __builtin_amdgcn_sched_barrier(0)
    Unit cur, nxt; int ui = 0;
    if (!S.next(0, cur)) return;
    f32x4 acc[2][2][4][2];
#pragma unroll
    for (int a = 0; a < 2; ++a)
#pragma unroll
        for (int b = 0; b < 2; ++b)
#pragma unroll
            for (int m = 0; m < 4; ++m)
#pragma unroll
                for (int n = 0; n < 2; ++n) acc[a][b][m][n] = (f32x4){0.f, 0.f, 0.f, 0.f};
    bf16x8 At[4][2], B0[2][2], B1[2][2];
    const char* cA = (const char*)g.A + (size_t)cur.pm * tstep + (size_t)cur.ko * 2; const char* cB = (const char*)g.Bt + (size_t)cur.pn * tstep + (size_t)cur.ko * 2;
    S.a_ready(cur);
    if constexpr (SP2) {
        PG8_STAGE(PG8_SB(0, 0), cB, voffB); PG8_STAGE(PG8_SB(0, 1), cB + hstep, voffB); PG8_STAGE(PG8_SA(0, 0), cA, voffA); PG8_STAGE(PG8_SA(0, 1), cA + hstep, voffA);
        if (wr == 1) PG8_BAR;
        PG8_WAIT_V(2); PG8_BAR;
        PG8_STAGE(PG8_SB(1, 0), cB + kstep, voffB); PG8_STAGE(PG8_SA(1, 0), cA + kstep, voffA); PG8_STAGE(PG8_SB(1, 1), cB + hstep + kstep, voffB);
        PG8_WAIT_V(6); PG8_BAR;
    } else {
        PG8_STAGE(PG8_SB(0, 0), cB, voffB); PG8_STAGE(PG8_SA(0, 0), cA, voffA); PG8_STAGE(PG8_SB(0, 1), cB + hstep, voffB); PG8_STAGE(PG8_SA(0, 1), cA + hstep, voffA);
        if (wr == 1) PG8_BAR;
        PG8_WAIT_V(4); PG8_BAR;
        PG8_STAGE(PG8_SB(1, 0), cB + kstep, voffB); PG8_STAGE(PG8_SA(1, 0), cA + kstep, voffA); PG8_STAGE(PG8_SB(1, 1), cB + hstep + kstep, voffB);
        PG8_WAIT_V(6); PG8_BAR;
    }
    for (;;) {
        const bool has_next = S.next(ui + 1, nxt);
        const char* nA = has_next ? (const char*)g.A + (size_t)nxt.pm * tstep + (size_t)nxt.ko * 2 : cA; const char* nB = has_next ? (const char*)g.Bt + (size_t)nxt.pn * tstep + (size_t)nxt.ko * 2 : cB;
        for (int t = 0; t < nt; t += 2) {
            const bool last = (t == nt - 2);
            const char* a1 = cA + (size_t)(t + 1) * kstep;
            const char* a2 = last ? nA : cA + (size_t)(t + 2) * kstep; const char* b2 = last ? nB : cB + (size_t)(t + 2) * kstep;
            const char* a3 = a2 + kstep; const char* b3 = b2 + kstep;
            if (last && has_next) S.a_ready(nxt);
            if constexpr (SP2) {
            PG8_LDB(B0, 0, 0); PG8_LDB(B1, 0, 1); PG8_SCHED; PG8_LDA(At, 0, 0); PG8_STAGE(PG8_SA(1, 1), a1 + hstep, voffA);
            PG8_WAIT_V(8); PG8_WAIT_L(0); PG8_BAR; PG8_MMA(0, 0, At, B0); PG8_MMA(0, 1, At, B1); PG8_BAR; PG8_SCHED;
            PG8_LDA(At, 0, 1); PG8_STAGE(PG8_SB(0, 0), b2, voffB); PG8_STAGE(PG8_SB(0, 1), b2 + hstep, voffB); PG8_STAGE(PG8_SA(0, 0), a2, voffA);
            PG8_WAIT_V(8); PG8_WAIT_L(0); PG8_BAR; PG8_MMA(1, 0, At, B0); PG8_MMA(1, 1, At, B1); PG8_BAR; PG8_SCHED;
            PG8_LDB(B0, 1, 0); PG8_LDB(B1, 1, 1); PG8_SCHED; PG8_LDA(At, 1, 0); PG8_STAGE(PG8_SA(0, 1), a2 + hstep, voffA);
            PG8_WAIT_V(8); PG8_WAIT_L(0); PG8_BAR; PG8_MMA(0, 0, At, B0); PG8_MMA(0, 1, At, B1); PG8_BAR; PG8_SCHED;
            PG8_LDA(At, 1, 1); PG8_STAGE(PG8_SB(1, 0), b3, voffB); PG8_STAGE(PG8_SB(1, 1), b3 + hstep, voffB); PG8_STAGE(PG8_SA(1, 0), a3, voffA);
            PG8_WAIT_V(8); PG8_WAIT_L(0); PG8_BAR; PG8_MMA(1, 0, At, B0); PG8_MMA(1, 1, At, B1); PG8_BAR; PG8_SCHED;
            } else {
            PG8_LDB(B0, 0, 0); PG8_SCHED; PG8_LDA(At, 0, 0); PG8_STAGE(PG8_SA(1, 1), a1 + hstep, voffA);
            PG8_WAIT_L(8); PG8_BAR; PG8_WAIT_L(0); PG8_MMA(0, 0, At, B0); PG8_BAR; PG8_SCHED;
            PG8_LDB(B1, 0, 1); PG8_STAGE(PG8_SB(0, 0), b2, voffB);
            PG8_BAR; PG8_WAIT_L(0); PG8_MMA(0, 1, At, B1); PG8_BAR;
            PG8_LDA(At, 0, 1); PG8_STAGE(PG8_SA(0, 0), a2, voffA);
            PG8_BAR; PG8_WAIT_L(0); PG8_MMA(1, 0, At, B0); PG8_BAR; PG8_SCHED;
            PG8_STAGE(PG8_SB(0, 1), b2 + hstep, voffB);
            PG8_WAIT_V(6); PG8_BAR; PG8_MMA(1, 1, At, B1); PG8_BAR;
            PG8_LDB(B0, 1, 0); PG8_SCHED; PG8_LDA(At, 1, 0); PG8_STAGE(PG8_SA(0, 1), a2 + hstep, voffA);
            PG8_WAIT_L(8); PG8_BAR; PG8_WAIT_L(0); PG8_MMA(0, 0, At, B0); PG8_BAR; PG8_SCHED;
            PG8_LDB(B1, 1, 1); PG8_STAGE(PG8_SB(1, 0), b3, voffB);
            PG8_BAR; PG8_WAIT_L(0); PG8_MMA(0, 1, At, B1); PG8_BAR;
            PG8_LDA(At, 1, 1); PG8_STAGE(PG8_SA(1, 0), a3, voffA);
            PG8_BAR; PG8_WAIT_L(0); PG8_MMA(1, 0, At, B0); PG8_BAR; PG8_SCHED;
            PG8_STAGE(PG8_SB(1, 1), b3 + hstep, voffB);
            PG8_WAIT_V(6); PG8_BAR; PG8_MMA(1, 1, At, B1); PG8_BAR;
            }
        }
        if constexpr (ALIGN_EPI) { if (wr == 0) PG8_BAR; }
        if constexpr (!Epi::AFTER_DRAIN) { E(acc, cur, wr, wc, fr, fq); S.done(cur); }
        if (!has_next) break;
#pragma unroll
        for (int a = 0; a < 2; ++a)
#pragma unroll
            for (int b = 0; b < 2; ++b)
#pragma unroll
                for (int m = 0; m < 4; ++m)
#pragma unroll
                    for (int n = 0; n < 2; ++n) acc[a][b][m][n] = (f32x4){0.f, 0.f, 0.f, 0.f};
        cur = nxt; cA = nA; cB = nB; ++ui;
        if constexpr (ALIGN_EPI) { if (wr == 1) PG8_BAR; }
    }
    PG8_WAIT_V(0);
    if constexpr (!ALIGN_EPI) { if (wr == 0) PG8_BAR; }
    PG8_BAR;
    if constexpr (Epi::AFTER_DRAIN) { E.fused(acc, cur, wr, wc, fr, fq, lds, wid, lane); S.done(cur); }
#undef PG8_SA
#undef PG8_SB
#undef PG8_STAGE
#undef PG8_LDA
#undef PG8_LDB
#undef PG8_MMA
#undef PG8_WAIT_V
#undef PG8_WAIT_L
#undef PG8_BAR
#undef PG8_SCHED
}
}

namespace att {
using bf16 = unsigned short;
constexpr int D = 128, NW = 8, QBLK = 32, KVBLK = 64;
constexpr float SCALE = 0.088388347648318440f;
constexpr float THR = 8.f;
constexpr int SHM_V = KVBLK * D * 2, SHM_K = KVBLK * D * 2;
constexpr int LDS_WS = 2 * SHM_V + 2 * SHM_K, LDS_RPB = LDS_WS + NW * 64 * 4, LDS_TOTAL = LDS_RPB + 2048;
using bf16x8 = __attribute__((ext_vector_type(8))) short;
using s16x4  = __attribute__((ext_vector_type(4))) short;
using f32x16 = __attribute__((ext_vector_type(16))) float;
using f32x8  = __attribute__((ext_vector_type(8))) float;
using u32x4  = __attribute__((ext_vector_type(4))) unsigned;
#define KSWZ(row, colB) ((row) * 256 + ((colB) ^ (((row) & 7) << 4)))
#define SBAR() __builtin_amdgcn_sched_barrier(0)
__device__ __forceinline__ int crow(int r, int hi) { return (r & 3) + 8 * (r >> 2) + 4 * hi; }
__device__ __forceinline__ unsigned cvtpk(float lo, float hi) {
  unsigned r; asm volatile("v_cvt_pk_bf16_f32 %0, %1, %2" : "=v"(r) : "v"(lo), "v"(hi)); return r;
}
template <typename TIn> struct Stage;
template <> struct Stage<bf16>  { using T = bf16x8;
  __device__ static __forceinline__ T ld8(const bf16* p) { return *reinterpret_cast<const bf16x8*>(p); }
  __device__ static __forceinline__ bf16x8 tobf(T x) { return x; } };
template <> struct Stage<float> { using T = f32x8;
  __device__ static __forceinline__ T ld8(const float* p) { return *reinterpret_cast<const f32x8*>(p); }
  __device__ static __forceinline__ bf16x8 tobf(T x) {
    u32x4 w = {cvtpk(x[0], x[1]), cvtpk(x[2], x[3]), cvtpk(x[4], x[5]), cvtpk(x[6], x[7])}; return *reinterpret_cast<bf16x8*>(&w); } };

__device__ __forceinline__ void partialSM(f32x16& p0, f32x16& p1, float& m_reg, float& mn, float& alpha) {
  constexpr float C = SCALE * 1.4426950408889634f;
  float pmax = p0[0]; for (int r = 1; r < 16; ++r) pmax = fmaxf(pmax, p0[r]); for (int r = 0; r < 16; ++r) pmax = fmaxf(pmax, p1[r]);
  { auto rr = __builtin_amdgcn_permlane32_swap(__float_as_uint(pmax), __float_as_uint(pmax), false, false);
    pmax = fmaxf(__uint_as_float(rr[0]), __uint_as_float(rr[1])); }
  if (__builtin_expect(__all(pmax - m_reg <= THR / SCALE), 1)) { mn = m_reg; alpha = 1.f; }
  else { mn = fmaxf(m_reg, pmax); alpha = __builtin_amdgcn_exp2f((m_reg - mn) * C); m_reg = mn; }
  float mnC = -mn * C;
  for (int r = 0; r < 16; ++r) p0[r] = fmaf(p0[r], C, mnC); for (int r = 0; r < 16; ++r) p1[r] = fmaf(p1[r], C, mnC);
  for (int r = 0; r < 16; ++r) p0[r] = __builtin_amdgcn_exp2f(p0[r]);
}
__device__ __forceinline__ void finishSM(f32x16& p0, f32x16& p1, float alpha, float& l_reg, bf16x8& pa0, bf16x8& pa1, bf16x8& pa2, bf16x8& pa3) {
  for (int r = 0; r < 16; ++r) p1[r] = __builtin_amdgcn_exp2f(p1[r]);
  float ps = 0; for (int r = 0; r < 16; ++r) ps += p0[r]; for (int r = 0; r < 16; ++r) ps += p1[r];
  { auto rr = __builtin_amdgcn_permlane32_swap(__float_as_uint(ps), __float_as_uint(ps), false, false);
    ps = __uint_as_float(rr[0]) + __uint_as_float(rr[1]); }
  l_reg = l_reg * alpha + ps;
#define PK4(P, BASE, OUT) do { unsigned a0 = cvtpk(P[BASE + 0], P[BASE + 1]), a1 = cvtpk(P[BASE + 2], P[BASE + 3]);   \
    unsigned b0 = cvtpk(P[BASE + 4], P[BASE + 5]), b1 = cvtpk(P[BASE + 6], P[BASE + 7]);                              \
    auto r0 = __builtin_amdgcn_permlane32_swap(a0, b0, false, false); auto r1 = __builtin_amdgcn_permlane32_swap(a1, b1, false, false); \
    u32x4 w = {r0[0], r1[0], r0[1], r1[1]}; OUT = *reinterpret_cast<bf16x8*>(&w); } while (0)
  PK4(p0, 0, pa0); PK4(p0, 8, pa1); PK4(p1, 0, pa2); PK4(p1, 8, pa3);
#undef PK4
}
__device__ __forceinline__ void qkt(f32x16& p0, f32x16& p1, const bf16* Ks, const bf16x8* qr, int r32, int hi) {
  p0 = f32x16{}; p1 = f32x16{};
  for (int d0 = 0; d0 < 8; ++d0) { int cb = (d0 * 16 + hi * 8) * 2;
    bf16x8 b0 = *reinterpret_cast<const bf16x8*>((const char*)Ks + KSWZ(r32, cb));
    bf16x8 b1 = *reinterpret_cast<const bf16x8*>((const char*)Ks + KSWZ(32 + r32, cb));
    p0 = __builtin_amdgcn_mfma_f32_32x32x16_bf16(b0, qr[d0], p0, 0, 0, 0);
    p1 = __builtin_amdgcn_mfma_f32_32x32x16_bf16(b1, qr[d0], p1, 0, 0, 0); }
}
__device__ __forceinline__ int v_st(int k, int c) { const int kk = (k & ~0xC) | ((k & 4) << 1) | ((k & 8) >> 1); return ((kk >> 3) * 4 + (c >> 5)) * 512 + ((kk & 7) * 32 + (c & 31)) * 2; }
__device__ __forceinline__ int v_rd_base(int lane) { return ((lane & 3) << 3) | (((lane >> 2) & 3) << 6) | (((lane >> 4) & 1) << 5) | (((lane >> 5) & 1) << 8); }
constexpr int v_rd_off(int d0, int ks, int half) { return d0 * 512 + ks * 4096 + half * 2048; }
template <int OFF> __device__ __forceinline__ s16x4 tr_read(int vb) {
  s16x4 r; asm volatile("ds_read_b64_tr_b16 %0, %1 offset:%2" : "=&v"(r) : "v"(vb), "i"(OFF) : "memory"); return r;
}
template <int D0> __device__ __forceinline__ void pv_one(f32x16& od, int vb, bf16x8 pa0, bf16x8 pa1, bf16x8 pa2, bf16x8 pa3) {
  const s16x4 l0 = tr_read<v_rd_off(D0, 0, 0)>(vb), h0 = tr_read<v_rd_off(D0, 0, 1)>(vb), l1 = tr_read<v_rd_off(D0, 1, 0)>(vb), h1 = tr_read<v_rd_off(D0, 1, 1)>(vb);
  const s16x4 l2 = tr_read<v_rd_off(D0, 2, 0)>(vb), h2 = tr_read<v_rd_off(D0, 2, 1)>(vb), l3 = tr_read<v_rd_off(D0, 3, 0)>(vb), h3 = tr_read<v_rd_off(D0, 3, 1)>(vb);
  asm volatile("s_waitcnt lgkmcnt(0)" ::: "memory"); SBAR();
#define PK(L, H) (bf16x8){L[0], L[1], L[2], L[3], H[0], H[1], H[2], H[3]}
  od = __builtin_amdgcn_mfma_f32_32x32x16_bf16(pa0, PK(l0, h0), od, 0, 0, 0);
  od = __builtin_amdgcn_mfma_f32_32x32x16_bf16(pa1, PK(l1, h1), od, 0, 0, 0);
  od = __builtin_amdgcn_mfma_f32_32x32x16_bf16(pa2, PK(l2, h2), od, 0, 0, 0);
  od = __builtin_amdgcn_mfma_f32_32x32x16_bf16(pa3, PK(l3, h3), od, 0, 0, 0);
#undef PK
}
__device__ __forceinline__ void pv_d0(f32x16* o, int vb, bf16x8 pa0, bf16x8 pa1, bf16x8 pa2, bf16x8 pa3) {
  pv_one<0>(o[0], vb, pa0, pa1, pa2, pa3); pv_one<1>(o[1], vb, pa0, pa1, pa2, pa3); pv_one<2>(o[2], vb, pa0, pa1, pa2, pa3); pv_one<3>(o[3], vb, pa0, pa1, pa2, pa3);
}
typedef float f32x4g __attribute__((ext_vector_type(4)));
struct AUnit {
    const bf16* Q; const bf16* K; const bf16* V; bf16* O; const float* rpb;
    const float* qg; const float* rope; int t0;
    int ldq, ldk, ldo, ntiles, nband, band0, ctx0, qrow0;
};
__device__ __forceinline__ unsigned short f2bf1(float v) { return (unsigned short)(cvtpk(v, v) & 0xffffu); }

__device__ __forceinline__ void attn_unit_dense(const AUnit& U, char* lds) {
  int tid = threadIdx.x; asm volatile("" : "+v"(tid));
  const int wid = __builtin_amdgcn_readfirstlane(tid >> 6), lane = tid & 63, r32 = lane & 31, hi = lane >> 5;
  bf16* V_lds = (bf16*)lds; bf16* K_lds = (bf16*)(lds + 2 * SHM_V);
  float* ws = (float*)(lds + LDS_WS) + wid * 64; float* li_l = ws; float* al_l = ws + 32;
  float m_reg = -1e30f, l_reg = 0.f; f32x16 o[4] = {}; bf16x8 qr[8];
  const bf16* Qw = U.Q + (long)(wid * QBLK + r32) * U.ldq + hi * 8;
#pragma unroll
  for (int d0 = 0; d0 < 8; ++d0) qr[d0] = *reinterpret_cast<const bf16x8*>(Qw + d0 * 16);
  if (U.qg) {
    float x[8][8]; float ss = 0.f;
#pragma unroll
    for (int d0 = 0; d0 < 8; ++d0) { const u32x4 w = *reinterpret_cast<const u32x4*>(&qr[d0]);
#pragma unroll
      for (int k = 0; k < 4; ++k) { x[d0][2 * k] = __uint_as_float(w[k] << 16); x[d0][2 * k + 1] = __uint_as_float(w[k] & 0xffff0000u); ss += x[d0][2 * k] * x[d0][2 * k] + x[d0][2 * k + 1] * x[d0][2 * k + 1]; } }
    ss += __shfl_xor(ss, 32);
    const float rms = 1.0f / sqrtf(ss * (1.0f / 128.0f) + 1e-6f);
#pragma unroll
    for (int d0 = 0; d0 < 8; ++d0) { const float* gp = U.qg + d0 * 16 + hi * 8; const f32x4g ga = *reinterpret_cast<const f32x4g*>(gp), gb = *reinterpret_cast<const f32x4g*>(gp + 4);
#pragma unroll
      for (int k = 0; k < 4; ++k) { x[d0][k] *= rms * ga[k]; x[d0][4 + k] *= rms * gb[k]; } }
    if (U.rope) { const float* rp = U.rope + ((long)(U.t0 + wid * QBLK + r32) * 64 + hi * 8) * 2;
#pragma unroll
      for (int d0 = 0; d0 < 4; ++d0)
#pragma unroll
        for (int k2 = 0; k2 < 4; ++k2) { const f32x4g cs = *reinterpret_cast<const f32x4g*>(rp + (d0 * 16 + 2 * k2) * 2);
          { const float a = x[d0][2 * k2], b = x[d0 + 4][2 * k2]; x[d0][2 * k2] = a * cs[0] - b * cs[1]; x[d0 + 4][2 * k2] = b * cs[0] + a * cs[1]; }
          { const float a = x[d0][2 * k2 + 1], b = x[d0 + 4][2 * k2 + 1]; x[d0][2 * k2 + 1] = a * cs[2] - b * cs[3]; x[d0 + 4][2 * k2 + 1] = b * cs[2] + a * cs[3]; } } }
#pragma unroll
    for (int d0 = 0; d0 < 8; ++d0) { u32x4 w = {cvtpk(x[d0][0], x[d0][1]), cvtpk(x[d0][2], x[d0][3]), cvtpk(x[d0][4], x[d0][5]), cvtpk(x[d0][6], x[d0][7])}; qr[d0] = *reinterpret_cast<bf16x8*>(&w); }
  }
  const int sr = tid >> 4, sc = (tid & 15) * 8, vst0 = v_st(sr, sc), vst1 = v_st(32 + sr, sc);
  const int vb0 = (int)(uintptr_t)V_lds + v_rd_base(lane);
  struct { bf16x8 vs0, vs1, ks0, ks1; } sr_[2];
#define D_SLOAD(i, k0) do { sr_[i].vs0 = *reinterpret_cast<const bf16x8*>(U.V + (long)((k0) + sr) * U.ldk + sc); sr_[i].vs1 = *reinterpret_cast<const bf16x8*>(U.V + (long)((k0) + 32 + sr) * U.ldk + sc); \
    sr_[i].ks0 = *reinterpret_cast<const bf16x8*>(U.K + (long)((k0) + sr) * U.ldk + sc); sr_[i].ks1 = *reinterpret_cast<const bf16x8*>(U.K + (long)((k0) + 32 + sr) * U.ldk + sc); } while (0)
#define D_SWRITE(b, i) do { *(bf16x8*)((char*)V_lds + (b) * SHM_V + vst0) = sr_[i].vs0; *(bf16x8*)((char*)V_lds + (b) * SHM_V + vst1) = sr_[i].vs1; const int kc_ = sc * 2; \
    *(bf16x8*)((char*)K_lds + (b) * SHM_K + KSWZ(sr, kc_)) = sr_[i].ks0; *(bf16x8*)((char*)K_lds + (b) * SHM_K + KSWZ(32 + sr, kc_)) = sr_[i].ks1; } while (0)
#define D_SWAIT() asm volatile("s_waitcnt vmcnt(4)" ::: "memory")
#define D_RESC(a) do { if (__any((a) < 1.f)) { if (hi == 0) al_l[r32] = (a); asm volatile("s_waitcnt lgkmcnt(0)" ::: "memory"); \
    _Pragma("unroll") for (int d = 0; d < 4; ++d) _Pragma("unroll") for (int r = 0; r < 16; ++r) o[d][r] *= al_l[crow(r, hi)]; } } while (0)
  f32x16 pA0, pA1, pB0, pB1; float mnA, mnB, alA, alB; bf16x8 pa0, pa1, pa2, pa3; const int NT = U.ntiles;
  constexpr int SE = 0, SO = 1;
  D_SLOAD(SE, 0); asm volatile("s_waitcnt vmcnt(0)" ::: "memory"); D_SWRITE(0, SE); __syncthreads();
  qkt(pA0, pA1, K_lds, qr, r32, hi); partialSM(pA0, pA1, m_reg, mnA, alA);
  D_SLOAD(SO, KVBLK); if (2 < NT) D_SLOAD(SE, 2 * KVBLK);
  D_SWAIT(); D_SWRITE(1, SO); __syncthreads();
  for (int j = 1; j + 1 < NT; j += 2) {
    SBAR(); qkt(pB0, pB1, (const bf16*)((const char*)K_lds + SHM_K), qr, r32, hi);
    finishSM(pA0, pA1, alA, l_reg, pa0, pa1, pa2, pa3); SBAR();
    D_SLOAD(SO, (j + 2) * KVBLK); SBAR();
    pv_d0(o, vb0, pa0, pa1, pa2, pa3); partialSM(pB0, pB1, m_reg, mnB, alB);
    __syncthreads(); D_SWAIT(); D_SWRITE(0, SE);
    D_RESC(alB); __syncthreads();
    SBAR(); qkt(pA0, pA1, K_lds, qr, r32, hi);
    finishSM(pB0, pB1, alB, l_reg, pa0, pa1, pa2, pa3); SBAR();
    if (j + 3 < NT) D_SLOAD(SE, (j + 3) * KVBLK); SBAR();
    pv_d0(o, vb0 + (int)SHM_V, pa0, pa1, pa2, pa3); partialSM(pA0, pA1, m_reg, mnA, alA);
    __syncthreads(); D_SWAIT(); D_SWRITE(1, SO);
    D_RESC(alA); __syncthreads();
  }
  SBAR(); qkt(pB0, pB1, (const bf16*)((const char*)K_lds + SHM_K), qr, r32, hi);
  finishSM(pA0, pA1, alA, l_reg, pa0, pa1, pa2, pa3); SBAR();
  pv_d0(o, vb0, pa0, pa1, pa2, pa3); partialSM(pB0, pB1, m_reg, mnB, alB);
  __syncthreads(); D_RESC(alB);
  finishSM(pB0, pB1, alB, l_reg, pa0, pa1, pa2, pa3); SBAR();
  pv_d0(o, vb0 + (int)SHM_V, pa0, pa1, pa2, pa3);
  if (hi == 0) li_l[r32] = l_reg; asm volatile("s_waitcnt lgkmcnt(0)" ::: "memory");
  float rli[16];
#pragma unroll
  for (int r = 0; r < 16; ++r) rli[r] = __builtin_amdgcn_rcpf(li_l[crow(r, hi)]);
  bf16* Ow = U.O + (long)(wid * QBLK) * U.ldo;
#pragma unroll
  for (int r = 0; r < 16; ++r) { const int orow = crow(r, hi);
#pragma unroll
    for (int d0 = 0; d0 < 4; ++d0) Ow[(long)orow * U.ldo + d0 * 32 + r32] = f2bf1(o[d0][r] * rli[r]); }
  __syncthreads();
#undef D_SLOAD
#undef D_SWRITE
#undef D_SWAIT
#undef D_RESC
}

__device__ __forceinline__ void attn_unit(const AUnit& U, char* lds) {
  int tid = threadIdx.x; asm volatile("" : "+v"(tid));
  const int wid = __builtin_amdgcn_readfirstlane(tid >> 6), lane = tid & 63, r32 = lane & 31, hi = lane >> 5;
  bf16* V_lds = (bf16*)lds; bf16* K_lds = (bf16*)(lds + 2 * SHM_V);
  float* ws = (float*)(lds + LDS_WS) + wid * 64; float* li_l = ws; float* al_l = ws + 32;
  float* rpbL = (float*)(lds + LDS_RPB);
  const int nband = U.nband, nt = U.ntiles;
  if (nband > 0 && tid < 465) rpbL[tid] = U.rpb[tid] * (1.0f / SCALE);
  float m_reg = -1e30f, l_reg = 0.f; f32x16 o[4] = {}; bf16x8 qr[8];
  const bf16* Qw = U.Q + (long)(wid * QBLK + r32) * U.ldq + hi * 8;
#pragma unroll
  for (int d0 = 0; d0 < 8; ++d0) qr[d0] = *reinterpret_cast<const bf16x8*>(Qw + d0 * 16);
  if (U.qg) {
    float x[8][8]; float ss = 0.f;
#pragma unroll
    for (int d0 = 0; d0 < 8; ++d0) { const u32x4 w = *reinterpret_cast<const u32x4*>(&qr[d0]);
#pragma unroll
      for (int k = 0; k < 4; ++k) { x[d0][2 * k] = __uint_as_float(w[k] << 16); x[d0][2 * k + 1] = __uint_as_float(w[k] & 0xffff0000u); ss += x[d0][2 * k] * x[d0][2 * k] + x[d0][2 * k + 1] * x[d0][2 * k + 1]; } }
    ss += __shfl_xor(ss, 32);
    const float rms = 1.0f / sqrtf(ss * (1.0f / 128.0f) + 1e-6f);
#pragma unroll
    for (int d0 = 0; d0 < 8; ++d0) { const float* gp = U.qg + d0 * 16 + hi * 8; const f32x4g ga = *reinterpret_cast<const f32x4g*>(gp), gb = *reinterpret_cast<const f32x4g*>(gp + 4);
#pragma unroll
      for (int k = 0; k < 4; ++k) { x[d0][k] *= rms * ga[k]; x[d0][4 + k] *= rms * gb[k]; } }
    if (U.rope) { const float* rp = U.rope + ((long)(U.t0 + wid * QBLK + r32) * 64 + hi * 8) * 2;
#pragma unroll
      for (int d0 = 0; d0 < 4; ++d0)
#pragma unroll
        for (int k2 = 0; k2 < 4; ++k2) { const f32x4g cs = *reinterpret_cast<const f32x4g*>(rp + (d0 * 16 + 2 * k2) * 2);
          { const float a = x[d0][2 * k2], b = x[d0 + 4][2 * k2]; x[d0][2 * k2] = a * cs[0] - b * cs[1]; x[d0 + 4][2 * k2] = b * cs[0] + a * cs[1]; }
          { const float a = x[d0][2 * k2 + 1], b = x[d0 + 4][2 * k2 + 1]; x[d0][2 * k2 + 1] = a * cs[2] - b * cs[3]; x[d0 + 4][2 * k2 + 1] = b * cs[2] + a * cs[3]; } } }
#pragma unroll
    for (int d0 = 0; d0 < 8; ++d0) { u32x4 w = {cvtpk(x[d0][0], x[d0][1]), cvtpk(x[d0][2], x[d0][3]), cvtpk(x[d0][4], x[d0][5]), cvtpk(x[d0][6], x[d0][7])}; qr[d0] = *reinterpret_cast<bf16x8*>(&w); }
  }
  const int sr = tid >> 4, sc = (tid & 15) * 8, vst0 = v_st(sr, sc), vst1 = v_st(32 + sr, sc);
  const int vb0 = (int)(uintptr_t)V_lds + v_rd_base(lane);
  const int gr = U.qrow0 + (wid >> 1), qc = (wid & 1) * 32 + r32;
  const int rstart = min(max(gr - 4, 0), 24), cs = min(max(qc - 8, 0), 48);
  bf16x8 vs0, vs1, ks0, ks1;
#define A_KBASE(j) (((j) < nband) ? (U.band0 + (j)) * KVBLK : U.ctx0 + ((j) - nband) * KVBLK)
#define A_SLOAD(k0) do { vs0 = *reinterpret_cast<const bf16x8*>(U.V + (long)((k0) + sr) * U.ldk + sc); vs1 = *reinterpret_cast<const bf16x8*>(U.V + (long)((k0) + 32 + sr) * U.ldk + sc); \
    ks0 = *reinterpret_cast<const bf16x8*>(U.K + (long)((k0) + sr) * U.ldk + sc); ks1 = *reinterpret_cast<const bf16x8*>(U.K + (long)((k0) + 32 + sr) * U.ldk + sc); } while (0)
#define A_SWRITE(b) do { *(bf16x8*)((char*)V_lds + (b) * SHM_V + vst0) = vs0; *(bf16x8*)((char*)V_lds + (b) * SHM_V + vst1) = vs1; const int kc_ = sc * 2; \
    *(bf16x8*)((char*)K_lds + (b) * SHM_K + KSWZ(sr, kc_)) = ks0; *(bf16x8*)((char*)K_lds + (b) * SHM_K + KSWZ(32 + sr, kc_)) = ks1; } while (0)
  { const int k0 = A_KBASE(0); A_SLOAD(k0); }
  A_SWRITE(0); __syncthreads();
  for (int j = 0; j < nt; ++j) {
    const int buf = j & 1;
    if (j + 1 < nt) { const int k1 = A_KBASE(j + 1); A_SLOAD(k1); }
    bool active = true; int dr = 0; const bool band = j < nband;
    if (band) { const int krow = U.band0 + j; active = (krow >= rstart) && (krow < rstart + 8); dr = krow - gr; }
    if (active) {
      f32x16 p0, p1; float mn, alpha; bf16x8 pa0, pa1, pa2, pa3;
      SBAR(); qkt(p0, p1, (const bf16*)((const char*)K_lds + buf * SHM_K), qr, r32, hi);
      if (band) {
        const float* brow = rpbL + (dr + 7) * 31 + 15;
#pragma unroll
        for (int r = 0; r < 16; ++r) {
          const int kc0 = crow(r, hi), kc1 = kc0 + 32;
          { const bool ok = (kc0 >= cs) && (kc0 < cs + 16); const int dc = min(max(kc0 - qc, -15), 15); const float b = brow[dc]; p0[r] = ok ? p0[r] + b : -1e30f; }
          { const bool ok = (kc1 >= cs) && (kc1 < cs + 16); const int dc = min(max(kc1 - qc, -15), 15); const float b = brow[dc]; p1[r] = ok ? p1[r] + b : -1e30f; }
        }
      }
      partialSM(p0, p1, m_reg, mn, alpha);
      if (__any(alpha < 1.f)) { if (hi == 0) al_l[r32] = alpha; asm volatile("s_waitcnt lgkmcnt(0)" ::: "memory");
#pragma unroll
        for (int d = 0; d < 4; ++d)
#pragma unroll
          for (int r = 0; r < 16; ++r) o[d][r] *= al_l[crow(r, hi)]; }
      finishSM(p0, p1, alpha, l_reg, pa0, pa1, pa2, pa3); SBAR();
      pv_d0(o, vb0 + buf * (int)SHM_V, pa0, pa1, pa2, pa3);
    }
    if (j + 1 < nt) A_SWRITE(buf ^ 1);
    __syncthreads();
  }
  if (hi == 0) li_l[r32] = l_reg; asm volatile("s_waitcnt lgkmcnt(0)" ::: "memory");
  float rli[16];
#pragma unroll
  for (int r = 0; r < 16; ++r) rli[r] = __builtin_amdgcn_rcpf(li_l[crow(r, hi)]);
  bf16* Ow = U.O + (long)(wid * QBLK) * U.ldo;
#pragma unroll
  for (int r = 0; r < 16; ++r) { const int orow = crow(r, hi);
#pragma unroll
    for (int d0 = 0; d0 < 4; ++d0) Ow[(long)orow * U.ldo + d0 * 32 + r32] = f2bf1(o[d0][r] * rli[r]); }
#undef A_KBASE
#undef A_SLOAD
#undef A_SWRITE
}
}

constexpr size_t MiB = 1u << 20;
constexpr size_t WS_CTL = 0, CTL_ZERO_BYTES = 1 * MiB;
constexpr size_t WS_MOD = 1 * MiB;
constexpr size_t WS_ROPE = 2 * MiB;
constexpr size_t WS_POOLW = 3 * MiB;
constexpr size_t WS_WINAB = 4 * MiB;
constexpr size_t WS_WOUTAB = WS_WINAB + (size_t)2 * 3072 * 2048 * 2;
constexpr size_t WS_WINCD = WS_WOUTAB + (size_t)2 * 2048 * 2048 * 2;
constexpr size_t WS_WOUTCD = WS_WINCD + (size_t)2 * 6144 * 2048 * 2;
constexpr size_t WS_WGU = WS_WOUTCD + (size_t)2 * 2048 * 2048 * 2;
constexpr size_t WS_WDN = WS_WGU + (size_t)4 * NGU * 2048 * 2;
constexpr size_t WS_H = WS_WDN + (size_t)4 * 2048 * FFH * 2;
constexpr size_t WS_PROJ = WS_H + (size_t)MTOK * DM * 2;
constexpr size_t WS_MIX = WS_PROJ + (size_t)MTOK * CD_IN * 2;
constexpr size_t WS_Y = WS_MIX + (size_t)MTOK * DM * 2;
constexpr size_t WS_Y2 = WS_Y + (size_t)MTOK * DM * 4;
constexpr size_t WS_X = WS_Y2 + (size_t)MTOK * DM * 4;
constexpr size_t WS_KLAB = WS_X + (size_t)MTOK * DM * 4;
constexpr size_t WS_VLAB = WS_KLAB + (size_t)2 * 2 * LKV * 512 * 2;
constexpr size_t WS_KLCD = WS_VLAB + (size_t)2 * 2 * LKV * 512 * 2;
constexpr size_t WS_VLCD = WS_KLCD + (size_t)2 * 2 * LKV * 1536 * 2;
constexpr size_t WS_END = WS_VLCD + (size_t)2 * 2 * LKV * 1536 * 2;
static_assert(WS_WINAB % 256 == 0 && WS_H % 256 == 0 && WS_KLAB % 256 == 0 && WS_END % 256 == 0, "alignment");
constexpr int CW_BAR = 4096;
constexpr int CW_Q = 16384;
constexpr size_t O_Y = 0;
__host__ __device__ constexpr size_t out_k_off(int i) { return i == 0 ? 25165824u : i == 1 ? 33554432u : i == 2 ? 58720256u : 67108864u; }
__host__ __device__ constexpr size_t out_v_off(int i) { return i == 0 ? 29360128u : i == 1 ? 46137344u : i == 2 ? 62914560u : 79691776u; }
constexpr size_t OUT_TOTAL = 92274688u;

constexpr int RING_OFF = 0, RING_BYTES = 131072;
constexpr int LDSCTL_OFF = RING_BYTES, MISC_OFF = LDSCTL_OFF + 320;
constexpr int LDS_BYTES = 147456;
static_assert(att::LDS_TOTAL <= RING_BYTES, "attention LDS fits the ring region");
constexpr int NWAVES = 8, NPHASES = 34;

#define GAS __attribute__((address_space(1)))
#define LAS __attribute__((address_space(3)))
typedef unsigned short bf16;
typedef unsigned v4u __attribute__((ext_vector_type(4)));
typedef float f32x4 __attribute__((ext_vector_type(4)));
typedef short bf16x8 __attribute__((ext_vector_type(8)));
typedef GAS unsigned gu32;
typedef GAS unsigned long long gu64;
#define RLX_AGENT __ATOMIC_RELAXED, __HIP_MEMORY_SCOPE_AGENT
#define LDS_WAIT() asm volatile("s_waitcnt lgkmcnt(0)" ::: "memory")
#define VM_WAIT() asm volatile("s_waitcnt vmcnt(0)" ::: "memory")
__device__ __forceinline__ unsigned long long rt() { return __builtin_amdgcn_s_memrealtime(); }
__device__ __forceinline__ unsigned f2bf(float f) { unsigned u = __builtin_bit_cast(unsigned, f); return (u + 0x7fffu + ((u >> 16) & 1u)) >> 16; }
__device__ __forceinline__ unsigned pk2(float lo, float hi) { return f2bf(lo) | (f2bf(hi) << 16); }

#define XB_TMO      128
#define XB_XCNT(j)  (256  + 64 * (j))
#define XB_XSUB(j)  (1280 + 64 * (j))
#define XB_XGEN(j)  (2304 + 64 * (j))
#define XB_TOP      3328
#define XB_TOPGEN   3392
#define XCD_BAR_WORDS 3456
#define XB_SPIN_CAP (1u << 18)

__device__ __forceinline__ unsigned xb_ld(unsigned* p)              { return __hip_atomic_load(p, __ATOMIC_RELAXED, __HIP_MEMORY_SCOPE_AGENT); }
__device__ __forceinline__ unsigned xb_add(unsigned* p, unsigned v) { return __hip_atomic_fetch_add(p, v, __ATOMIC_RELAXED, __HIP_MEMORY_SCOPE_AGENT); }
__device__ __forceinline__ unsigned xb_xcc_id() { return (unsigned)__builtin_amdgcn_s_getreg((3 << 11) | 20) & 0xFu; }
#define XB_SPIN(cond, bar) do { unsigned _sp = 0; while (cond) { __builtin_amdgcn_s_sleep(1); \
    if ((++_sp & 255u) == 0u) { if (xb_ld(&(bar)[XB_TMO])) break; if (_sp > XB_SPIN_CAP) { atomicAdd(&(bar)[XB_TMO], 1u); break; } } } } while (0)

struct XcdBarrier {
    unsigned* bar; unsigned x;
    volatile LAS unsigned* st;
};

__device__ __forceinline__ XcdBarrier xcd_barrier_post(unsigned* bar, volatile LAS unsigned* st) {
    XcdBarrier b; b.bar = bar; b.x = xb_xcc_id(); b.st = st;
    if (threadIdx.x == 0) (void)xb_add(&bar[XB_XCNT(b.x)], 1u);
    return b;
}
__device__ __forceinline__ void xcd_barrier_complete(unsigned* bar, unsigned x, unsigned& nloc, unsigned& nx) {
    const unsigned G = gridDim.x * gridDim.y * gridDim.z;
    unsigned sum, cnt, mine, sp = 0u;
    for (;;) {
        sum = 0u; cnt = 0u; mine = 0u;
#pragma unroll
        for (unsigned j = 0; j < 16; ++j) { const unsigned c = xb_ld(&bar[XB_XCNT(j)]); sum += c; cnt += (c > 0u) ? 1u : 0u; mine = (j == x) ? c : mine; }
        if (sum == G) break;
        __builtin_amdgcn_s_sleep(1);
        if ((++sp & 255u) == 0u) { if (xb_ld(&bar[XB_TMO])) break; if (sp > XB_SPIN_CAP) { atomicAdd(&bar[XB_TMO], 1u); break; } }
    }
    nloc = mine > 0u ? mine : 1u; nx = cnt > 0u ? cnt : 1u;
}

__device__ __forceinline__ void xcd_barrier(const XcdBarrier& b) {
    asm volatile("s_waitcnt vmcnt(0)" ::: "memory");
    __syncthreads();
    if (threadIdx.x == 0) {
        unsigned* bar = b.bar;
        __builtin_amdgcn_s_waitcnt(0);
        unsigned nloc = b.st[0], nx = b.st[1];
        if (nloc == 0u) { xcd_barrier_complete(bar, b.x, nloc, nx); b.st[0] = nloc; b.st[1] = nx; }
        const unsigned old = xb_add(&bar[XB_XSUB(b.x)], 1u);
        const unsigned gen = old / nloc;
        if (old + 1u == (gen + 1u) * nloc) {
            __builtin_amdgcn_fence(__ATOMIC_RELEASE, "agent");
            asm volatile("s_waitcnt vmcnt(0)" ::: "memory");
            const unsigned og = xb_add(&bar[XB_TOP], 1u);
            const unsigned tg = og / nx;
            if (og + 1u == (tg + 1u) * nx) xb_add(&bar[XB_TOPGEN], 1u);
            else XB_SPIN(xb_ld(&bar[XB_TOPGEN]) == tg, bar);
            __builtin_amdgcn_fence(__ATOMIC_ACQUIRE, "agent");
            xb_add(&bar[XB_XGEN(b.x)], 1u);
            asm volatile("s_waitcnt vmcnt(0)" ::: "memory");
        } else {
            XB_SPIN(xb_ld(&bar[XB_XGEN(b.x)]) == gen, bar);
            __builtin_amdgcn_fence(__ATOMIC_ACQUIRE, "agent");
            asm volatile("s_waitcnt vmcnt(0)" ::: "memory");
        }
    }
    __syncthreads();
}

struct Args { const float* in[31]; float* out; unsigned char* ws; int ph_lo, ph_hi; };
struct Frame {
    LAS unsigned char* lds; char* ldsg;
    volatile LAS unsigned* MISC;
    gu32* ctl;
    int vcu, G;
};
__device__ __forceinline__ int otid() { int t = threadIdx.x; asm volatile("" : "+v"(t)); return t; }
#define LANE_VARS const int tid_ = otid(), lane_ = tid_ & 63, wave_ = __builtin_amdgcn_readfirstlane(tid_ >> 6)

__device__ __forceinline__ float wave_sum(float v) {
#pragma unroll
    for (int o = 1; o < 64; o <<= 1) v += __shfl_xor(v, o);
    return v;
}
__device__ __forceinline__ float bf2f(unsigned short b) { return __builtin_bit_cast(float, (unsigned)b << 16); }
__device__ __forceinline__ float bflo(unsigned w) { return __builtin_bit_cast(float, w << 16); }
__device__ __forceinline__ float bfhi(unsigned w) { return __builtin_bit_cast(float, w & 0xffff0000u); }
__device__ __forceinline__ unsigned pkbf(float lo, float hi) { return pg8::cvt_pk_bf16(lo, hi); }
typedef unsigned u32x2v __attribute__((ext_vector_type(2)));
typedef float f32x16 __attribute__((ext_vector_type(16)));
__device__ __forceinline__ void unpack8(const v4u& w, float (&x)[8]) { x[0] = bflo(w.x); x[1] = bfhi(w.x); x[2] = bflo(w.y); x[3] = bfhi(w.y); x[4] = bflo(w.z); x[5] = bfhi(w.z); x[6] = bflo(w.w); x[7] = bfhi(w.w); }
__device__ __forceinline__ v4u pack8(const float (&x)[8]) { v4u w; w.x = pkbf(x[0], x[1]); w.y = pkbf(x[2], x[3]); w.z = pkbf(x[4], x[5]); w.w = pkbf(x[6], x[7]); return w; }

__device__ __forceinline__ void transpose_item(const float* W, int K, int N, bf16* WT, int mode, LAS float* scr, int item, int lane) {
    const int nblk = N / 64, kb = item / nblk, nb = item % nblk, k0 = 64 * kb, n0 = 64 * nb;
    int rb = n0; if (mode) rb = (n0 >> 7) * 256 + (n0 & 127) + (mode == 2 ? 128 : 0);
    float tv[64];
    const float* p = W + (size_t)k0 * N + n0 + lane;
#pragma unroll
    for (int i = 0; i < 64; ++i) tv[i] = __builtin_nontemporal_load(p + (size_t)i * N);
    const int c = lane & 7;
#pragma unroll
    for (int h = 0; h < 2; ++h) {
        if ((lane >> 5) == h) {
#pragma unroll
            for (int i = 0; i < 64; ++i) scr[i * 33 + (lane & 31)] = tv[i]; }
        LDS_WAIT(); asm volatile("" ::: "memory");
#pragma unroll
        for (int j = 0; j < 4; ++j) { const int n = (lane >> 3) + 8 * j; const LAS float* s = scr + (8 * c) * 33 + n;
            v4u o; o.x = pkbf(s[0 * 33], s[1 * 33]); o.y = pkbf(s[2 * 33], s[3 * 33]); o.z = pkbf(s[4 * 33], s[5 * 33]); o.w = pkbf(s[6 * 33], s[7 * 33]);
            *(GAS v4u*)(WT + (size_t)(rb + 32 * h + n) * K + k0 + 8 * c) = o; }
        LDS_WAIT(); asm volatile("" ::: "memory");
    }
}

constexpr int CI_OUT = 32 * 32, CI_GU = 32 * 88, CI_DN = 88 * 32;
__host__ __device__ constexpr int ci_in(int L) { return (L & 1) ? 32 * 96 : 32 * 48; }
__host__ __device__ constexpr int ci_layer(int L) { return ci_in(L) + CI_OUT + 2 * CI_GU + CI_DN; }
__host__ __device__ constexpr int ci_base(int L) { return L == 0 ? 0 : ci_base(L - 1) + ci_layer(L - 1); }
constexpr int CI_TOTAL = ci_base(3) + ci_layer(3);
static_assert(CI_TOTAL == 47104, "conversion items");
__host__ __device__ constexpr int conv_slot_end(int s) {
    return s == 0 ? 2560 : s == 1 ? 7960 : s == 2 ? 12260 : s == 3 ? 17160 : s == 4 ? 20010 : s == 5 ? 24310 : s == 6 ? 29210 : s == 7 ? 34610 : s == 8 ? 38910 : s == 9 ? 43810 : CI_TOTAL;
}
__host__ __device__ constexpr bool conv_deadlines_ok() {
    for (int i = 0; i < 4; ++i) {
        const int b = ci_base(i);
        if (conv_slot_end(i == 0 ? 0 : 3 * i) < b + ci_in(i)) return false;
        if (conv_slot_end(3 * i + 1) < b + ci_in(i) + CI_OUT) return false;
        if (conv_slot_end(3 * i + 2) < b + ci_in(i) + CI_OUT + 2 * CI_GU) return false;
        if (conv_slot_end(3 * i + 3) < b + ci_layer(i)) return false;
    }
    return true;
}
static_assert(conv_deadlines_ok(), "a weight matrix would be used before it is converted");
__device__ __forceinline__ void convert_items(const Args& A, int it0, int it1, int gw, int ngw, LAS float* scr, int lane) {
    unsigned char* ws = A.ws;
    for (int it = it0 + gw; it < it1; it += ngw) {
        int r = it, L = 0;
        if (r >= ci_base(3)) { L = 3; r -= ci_base(3); } else if (r >= ci_base(2)) { L = 2; r -= ci_base(2); } else if (r >= ci_base(1)) { L = 1; r -= ci_base(1); }
        const int j = L >> 1; const bool even = !(L & 1); const int iin = even ? 32 * 48 : 32 * 96;
        if (r < iin) {
            if (even) transpose_item(A.in[18] + (size_t)j * 2048 * 3072, 2048, 3072, (bf16*)(ws + WS_WINAB) + (size_t)j * 3072 * 2048, 0, scr, r, lane);
            else transpose_item(A.in[24] + (size_t)j * 2048 * 6144, 2048, 6144, (bf16*)(ws + WS_WINCD) + (size_t)j * 6144 * 2048, 0, scr, r, lane);
            continue; }
        r -= iin;
        if (r < CI_OUT) {
            if (even) transpose_item(A.in[19] + (size_t)j * 2048 * 2048, 2048, 2048, (bf16*)(ws + WS_WOUTAB) + (size_t)j * 2048 * 2048, 0, scr, r, lane);
            else transpose_item(A.in[25] + (size_t)j * 2048 * 2048, 2048, 2048, (bf16*)(ws + WS_WOUTCD) + (size_t)j * 2048 * 2048, 0, scr, r, lane);
            continue; }
        r -= CI_OUT;
        if (r < CI_GU) { transpose_item(A.in[28] + (size_t)L * 2048 * FFH, 2048, FFH, (bf16*)(ws + WS_WGU) + (size_t)L * NGU * 2048, 1, scr, r, lane); continue; } r -= CI_GU;
        if (r < CI_GU) { transpose_item(A.in[29] + (size_t)L * 2048 * FFH, 2048, FFH, (bf16*)(ws + WS_WGU) + (size_t)L * NGU * 2048, 2, scr, r, lane); continue; } r -= CI_GU;
        transpose_item(A.in[30] + (size_t)L * FFH * 2048, FFH, 2048, (bf16*)(ws + WS_WDN) + (size_t)L * 2048 * FFH, 0, scr, r, lane);
    }
}
template <int L>
__device__ __forceinline__ void ada_items(Frame& F, const Args& A, int first, int stride) {
    LANE_VARS;
    LAS float* S = (LAS float*)(F.lds);
    LAS f32x4* red = (LAS f32x4*)(F.lds + 24576);
    const float* c_lat = A.in[10]; const float* c_ctx = A.in[11]; const float* w_ada = A.in[12] + (size_t)L * 2048 * 12288; const float* b_ada = A.in[13] + (size_t)L * 12288;
    float* MOD = (float*)(A.ws + WS_MOD) + (size_t)L * 3 * 12288;
    if (first < 192) {
        for (int e = tid_; e < 3 * 2048; e += NWAVES * 64) { const int c = e >> 11, k = e & 2047; const float v = (c == 0) ? c_ctx[k] : c_lat[(c - 1) * 2048 + k]; S[e] = v / (1.0f + __expf(-v)); }
    }
    for (int it = first; it < 192; it += stride) {
        __syncthreads();
        const int cg = lane_ & 15, ks = lane_ >> 4, n = it * 64 + 4 * cg;
        const float* wp = w_ada + (size_t)(256 * wave_ + ks) * 12288 + n;
        f32x4 a0 = {0.f, 0.f, 0.f, 0.f}, a1 = a0, a2 = a0;
#pragma unroll 16
        for (int i = 0; i < 64; ++i) { const f32x4 w4 = __builtin_nontemporal_load((const f32x4*)(wp + (size_t)(4 * i) * 12288)); const int kk = 256 * wave_ + 4 * i + ks;
            a0 += w4 * S[kk]; a1 += w4 * S[2048 + kk]; a2 += w4 * S[4096 + kk]; }
#pragma unroll
        for (int e = 0; e < 4; ++e) { a0[e] += __shfl_xor(a0[e], 16); a0[e] += __shfl_xor(a0[e], 32); a1[e] += __shfl_xor(a1[e], 16); a1[e] += __shfl_xor(a1[e], 32); a2[e] += __shfl_xor(a2[e], 16); a2[e] += __shfl_xor(a2[e], 32); }
        if (lane_ < 16) { red[(wave_ * 3 + 0) * 16 + lane_] = a0; red[(wave_ * 3 + 1) * 16 + lane_] = a1; red[(wave_ * 3 + 2) * 16 + lane_] = a2; }
        __syncthreads();
        if (tid_ < 48) { const int c = tid_ >> 4, l = tid_ & 15; f32x4 s = red[(0 * 3 + c) * 16 + l];
#pragma unroll
            for (int w = 1; w < 8; ++w) s += red[(w * 3 + c) * 16 + l];
            const int nn = it * 64 + 4 * l; s += *(const f32x4*)(b_ada + nn);
            *(f32x4*)(MOD + (size_t)c * 12288 + nn) = s; }
    }
    __syncthreads();
}
#ifndef SIDE_MODE
#define SIDE_MODE 0
#endif
template <int L, int PART>
__device__ __forceinline__ void side_items(Frame& F, const Args& A, int ada_first, int ada_stride, int frac_lo, int frac_hi  , int m, int nm) {
    constexpr int slot = 1 + 3 * (L - 1) + PART, it0 = conv_slot_end(slot - 1), it1 = conv_slot_end(slot), n = it1 - it0;
    if constexpr (PART == 0 && L < 4) ada_items<L>(F, A, ada_first, ada_stride);
    LANE_VARS;
    convert_items(A, it0 + (n * frac_lo) / 10, it0 + (n * frac_hi) / 10, m * NWAVES + wave_, nm * NWAVES, (LAS float*)(F.lds + wave_ * 8448), lane_);
    __syncthreads();
}
template <int L, int PART>
__device__ __forceinline__ void prefix_work(Frame& F, const Args& A, int nwg) {
    const int G = F.G, rounds = (nwg + G - 1) / G, busy_last = nwg - (rounds - 1) * G, c = (int)blockIdx.x;
    if (busy_last >= G || ((G - busy_last) & 31)) { side_items<L, PART>(F, A, c, G, 0, 10, c, G); return; }
    if (c < busy_last) return;
    const int k = c - busy_last, nidle = G - busy_last, g = (k >> 3) & 3, m = ((k >> 5) << 3) | (k & 7), nm = nidle >> 2;
    const int lo = g == 0 ? 0 : (g == 1 ? 1 : (g == 2 ? 3 : 6)), hi = g == 0 ? 1 : (g == 1 ? 3 : (g == 2 ? 6 : 10));
    side_items<L, PART>(F, A, k, nidle, lo, hi, m, nm);
}
__device__ __forceinline__ bool split_roles(const Frame& F, int nwg, bool has_side, int& geff, int& c, int& n) {
    const int G = F.G, bx = (int)blockIdx.x;
    geff = G; c = bx; n = 0;
    if (SIDE_MODE == 1 || !has_side || (G & 7)) return true;
    const int rounds = (nwg + G - 1) / G; int need = (nwg + rounds - 1) / rounds; need = (need + 7) & ~7;
    if (need >= G) return true;
    geff = need; n = G - need;
    const int xcd = bx & 7, idx = bx >> 3, per = need >> 3;
    if (idx < per) { c = idx * 8 + xcd; return true; }
    c = (idx - per) * 8 + xcd; return false;
}
template <int L, int PART>
__device__ __forceinline__ void side_work(Frame& F, const Args& A, int k, int n) { side_items<L, PART>(F, A, k, n, 0, 10, k, n); }

__device__ __forceinline__ void p0_prologue(Frame& F, const Args& A) {
    LANE_VARS;
    unsigned char* ws = A.ws;
    ada_items<0>(F, A, F.vcu, F.G);
    {
        constexpr int NI = conv_slot_end(0);
        int start, cnt;
        { const int per = (NI + F.G - 1) / F.G; start = F.vcu * per; cnt = per; }
        int end = start + cnt; if (end > NI) end = NI;
        convert_items(A, start, end, wave_, NWAVES, (LAS float*)(F.lds + wave_ * 8448), lane_);
    }
    const int gt = F.vcu * (NWAVES * 64) + tid_, NT = F.G * NWAVES * 64;
    {
        constexpr int C_AB = 2 * 256 * 512 / 8, C_CD = 2 * 256 * 1536 / 8;
        for (int idx = gt; idx < 4 * C_AB + 4 * C_CD; idx += NT) {
            const float* src; bf16* dst; int W, e;
            if (idx < 4 * C_AB) { const int tsr = idx / C_AB; e = (idx % C_AB) * 8; const int j = tsr >> 1, isv = tsr & 1; W = 512;
                src = j ? (isv ? A.in[7] : A.in[6]) : (isv ? A.in[3] : A.in[2]); dst = (bf16*)(ws + (isv ? WS_VLAB : WS_KLAB)) + (size_t)j * 2 * LKV * 512; }
            else { const int q = idx - 4 * C_AB; const int tsr = q / C_CD; e = (q % C_CD) * 8; const int j = tsr >> 1, isv = tsr & 1; W = 1536;
                src = j ? (isv ? A.in[9] : A.in[8]) : (isv ? A.in[5] : A.in[4]); dst = (bf16*)(ws + (isv ? WS_VLCD : WS_KLCD)) + (size_t)j * 2 * LKV * 1536; }
            const int b = e / (256 * W), rem = e % (256 * W), p = rem / W, c = rem % W;
            const f32x4 x0 = *(const f32x4*)(src + e), x1 = *(const f32x4*)(src + e + 4);
            v4u o; o.x = pkbf(x0[0], x0[1]); o.y = pkbf(x0[2], x0[3]); o.z = pkbf(x1[0], x1[1]); o.w = pkbf(x1[2], x1[3]);
            *(v4u*)(dst + ((size_t)(b * LKV + LSEQ + p)) * W + c) = o;
        }
    }
    {
        float* ROPE = (float*)(ws + WS_ROPE);
        for (int idx = gt; idx < 2048 * 64; idx += NT) { const int t = idx >> 6, i = idx & 63, fi = i & 31; const int pos = (i < 32) ? (t >> 6) : (t & 63);
            double inv = 1.0; for (int q = 0; q < fi; ++q) inv *= 0.74989420933245582;
            const double rev = (double)pos * inv * 0.15915494309189535; const float fr = (float)(rev - __builtin_rint(rev));
            ROPE[2 * idx] = __builtin_amdgcn_cosf(fr); ROPE[2 * idx + 1] = __builtin_amdgcn_sinf(fr); }
    }
    {
        bf16* PW = (bf16*)(ws + WS_POOLW); const float* pw = A.in[20];
        for (int idx = gt; idx < 2 * 4 * 128 * 128; idx += NT) { const int k = idx & 127, n = (idx >> 7) & 127, jg = idx >> 14;
            PW[idx] = (bf16)(pkbf(pw[((size_t)jg * 128 + k) * 128 + n], 0.f) & 0xffffu); }
    }
}

__device__ __forceinline__ void p1_modulate_x(Frame& F, const Args& A) {
    LANE_VARS;
    const int gw = F.vcu * NWAVES + wave_, NGW = F.G * NWAVES;
    const float* MOD = (const float*)(A.ws + WS_MOD); bf16* H = (bf16*)(A.ws + WS_H);
    for (int row = gw; row < MTOK; row += NGW) {
        const float* src = (row < NCTX) ? A.in[0] + (size_t)row * DM : A.in[1] + (size_t)(row - NCTX) * DM;
        const int cond = (row < NCTX) ? 0 : 1 + ((row - NCTX) >> 11);
        const f32x4* x4 = (const f32x4*)src + lane_; const f32x4* sh = (const f32x4*)(MOD + (size_t)cond * 12288) + lane_; const f32x4* sc = (const f32x4*)(MOD + (size_t)cond * 12288 + 2048) + lane_;
        u32x2v* o = (u32x2v*)(H + (size_t)row * DM) + lane_;
#pragma unroll
        for (int j = 0; j < 8; ++j) { const f32x4 v = x4[64 * j], s = sc[64 * j], h = sh[64 * j]; const f32x4 r = v * (s + 1.0f) + h;
            u32x2v w; w.x = pkbf(r[0], r[1]); w.y = pkbf(r[2], r[3]); o[64 * j] = w; }
    }
}

template <bool XIN_F32, bool XOUT_F32>
__device__ __forceinline__ void ln_phase(Frame& F, const void* XA, const void* XB  , const bf16* D, const bf16* D2  ,
                                         void* Xo, const float* lg, const float* lb, const float* mod_sh  , bf16* H) {
    LANE_VARS;
    const int gw = F.vcu * NWAVES + wave_, NGW = F.G * NWAVES;
    for (int row = gw; row < MTOK; row += NGW) {
        const u32x2v* d4 = (const u32x2v*)(D + (size_t)row * DM) + lane_;
        f32x4 v[8]; float s = 0.f;
#pragma unroll
        for (int j = 0; j < 8; ++j) {
            f32x4 x;
            if (XIN_F32) x = ((const f32x4*)((row < NCTX) ? (const float*)XA + (size_t)row * DM : (const float*)XB + (size_t)(row - NCTX) * DM) + lane_)[64 * j];
            else { const u32x2v xw = ((const u32x2v*)((row < NCTX) ? (const bf16*)XA + (size_t)row * DM : (const bf16*)XB + (size_t)(row - NCTX) * DM) + lane_)[64 * j]; x = (f32x4){bflo(xw.x), bfhi(xw.x), bflo(xw.y), bfhi(xw.y)}; }
            const u32x2v dw = d4[64 * j]; f32x4 dd = {bflo(dw.x), bfhi(dw.x), bflo(dw.y), bfhi(dw.y)};
            if (D2) { const u32x2v ew = ((const u32x2v*)(D2 + (size_t)row * DM) + lane_)[64 * j]; dd += (f32x4){bflo(ew.x), bfhi(ew.x), bflo(ew.y), bfhi(ew.y)}; }
            v[j] = x * ALPHA_RES + dd; s += (v[j][0] + v[j][1]) + (v[j][2] + v[j][3]); }
        const float mean = wave_sum(s) * (1.0f / DM); float q = 0.f;
#pragma unroll
        for (int j = 0; j < 8; ++j) { v[j] = v[j] - mean; q += (v[j][0] * v[j][0] + v[j][1] * v[j][1]) + (v[j][2] * v[j][2] + v[j][3] * v[j][3]); }
        const float rstd = 1.0f / sqrtf(wave_sum(q) * (1.0f / DM) + LN_EPS);
        const int cond = (row < NCTX) ? 0 : 1 + ((row - NCTX) >> 11);
        const f32x4* g4 = (const f32x4*)lg + lane_; const f32x4* b4 = (const f32x4*)lb + lane_;
        const float* msh = mod_sh ? mod_sh : lg;
        const f32x4* sh = (const f32x4*)(msh + (size_t)cond * 12288) + lane_; const f32x4* sc = (const f32x4*)(msh + (size_t)cond * 12288 + 2048) + lane_;
        u32x2v* o = (u32x2v*)(H + (size_t)row * DM) + lane_;
#pragma unroll
        for (int j = 0; j < 8; ++j) { const f32x4 x = v[j] * rstd * g4[64 * j] + b4[64 * j];
            if (XOUT_F32) ((f32x4*)((float*)Xo + (size_t)row * DM) + lane_)[64 * j] = x;
            else { u32x2v w; w.x = pkbf(x[0], x[1]); w.y = pkbf(x[2], x[3]); ((u32x2v*)((bf16*)Xo + (size_t)row * DM) + lane_)[64 * j] = w; }
            if (mod_sh) { const f32x4 r = x * (sc[64 * j] + 1.0f) + sh[64 * j]; u32x2v w; w.x = pkbf(r[0], r[1]); w.y = pkbf(r[2], r[3]); o[64 * j] = w; } }
    }
}

__device__ __forceinline__ void prep_ab(Frame& F, const Args& A, int layer, int j) {
    LANE_VARS;
    const int gw = F.vcu * NWAVES + wave_, NGW = F.G * NWAVES;
    bf16* PROJ = (bf16*)(A.ws + WS_PROJ); const float* ROPE = (const float*)(A.ws + WS_ROPE);
    bf16* KL = (bf16*)(A.ws + WS_KLAB) + (size_t)j * 2 * LKV * 512;
    float* outk = A.out + out_k_off(layer);
    const int l16 = lane_ & 15, hg = lane_ >> 4;
    float kg[8];
    { const f32x4* k4 = (const f32x4*)(A.in[23] + j * 128 + l16 * 8); const f32x4 c = k4[0], d = k4[1];
#pragma unroll
      for (int e = 0; e < 4; ++e) { kg[e] = c[e]; kg[4 + e] = d[e]; } }
    for (int row = gw; row < MTOK; row += NGW) {
        bf16* p = PROJ + (size_t)row * AB_IN + 2048 + hg * 128 + l16 * 8;
        const bool lat = row >= NCTX; const int t = (row - NCTX) & 2047, lbt = (row - NCTX) >> 11;
        const v4u raw = *(const v4u*)p; float x[8]; unpack8(raw, x);
        float ss = 0.f;
#pragma unroll
        for (int e = 0; e < 8; ++e) ss += x[e] * x[e];
        ss += __shfl_xor(ss, 1); ss += __shfl_xor(ss, 2); ss += __shfl_xor(ss, 4); ss += __shfl_xor(ss, 8);
        const float rms = 1.0f / sqrtf(ss * (1.0f / 128.0f) + RMS_EPS);
#pragma unroll
        for (int e = 0; e < 8; ++e) x[e] = x[e] * rms * kg[e];
        if (lat) {
            const f32x4* cs4 = (const f32x4*)(ROPE + ((size_t)t * 64 + (l16 & 7) * 8) * 2);
#pragma unroll
            for (int e2 = 0; e2 < 4; ++e2) { const f32x4 cs = cs4[e2];
                { const float pr = __shfl_xor(x[2 * e2], 8); x[2 * e2] = (l16 < 8) ? x[2 * e2] * cs[0] - pr * cs[1] : x[2 * e2] * cs[0] + pr * cs[1]; }
                { const float pr = __shfl_xor(x[2 * e2 + 1], 8); x[2 * e2 + 1] = (l16 < 8) ? x[2 * e2 + 1] * cs[2] - pr * cs[3] : x[2 * e2 + 1] * cs[2] + pr * cs[3]; } }
            *(v4u*)(KL + ((size_t)(lbt * LKV + t)) * 512 + hg * 128 + l16 * 8) = pack8(x);
        } else {
            *(v4u*)p = pack8(x); float* ok = outk + (size_t)row * 512 + hg * 128 + l16 * 8;
            *(f32x4*)ok = (f32x4){x[0], x[1], x[2], x[3]}; *(f32x4*)(ok + 4) = (f32x4){x[4], x[5], x[6], x[7]};
        }
    }
}

__device__ __forceinline__ void pool_unit(const Args& A, int j, int unit) {
    LANE_VARS;
    const int r32 = lane_ & 31, hi = lane_ >> 5;
    const bf16* PROJ = (const bf16*)(A.ws + WS_PROJ);
    const bf16* PW = (const bf16*)(A.ws + WS_POOLW) + (size_t)j * 4 * 128 * 128; const float* ps = A.in[21] + j * 512; bf16* MIX = (bf16*)(A.ws + WS_MIX);
    const int row = unit * 64 + (wave_ >> 2) * 32 + r32;
    int seq0, L, t; if (row < NCTX) { seq0 = row & ~255; L = 256; t = row & 255; } else { seq0 = NCTX + ((row - NCTX) & ~2047); L = 2048; t = (row - NCTX) & 2047; }
    { const int g = wave_ & 3;
        const int w = 2 << g;
        const int lo = max(t - w / 2, 0), hi_ = min(t - w / 2 + w - 1, L - 1); const float inv = 1.0f / (float)(hi_ - lo + 1);
        float s[8][8];
#pragma unroll
        for (int d0 = 0; d0 < 8; ++d0)
#pragma unroll
            for (int e = 0; e < 8; ++e) s[d0][e] = 0.f;
        const bf16* cbase = PROJ + g * 128 + hi * 8;
        for (int rr = lo; rr <= hi_; ++rr) { const bf16* pr = cbase + (size_t)(seq0 + rr) * AB_IN;
#pragma unroll
            for (int d0 = 0; d0 < 8; ++d0) { const v4u raw = *(const v4u*)(pr + d0 * 16); float x[8]; unpack8(raw, x);
#pragma unroll
                for (int e = 0; e < 8; ++e) s[d0][e] += x[e]; } }
        att::bf16x8 Bf[8];
        { const bf16* pr = cbase + (size_t)row * AB_IN;
#pragma unroll
          for (int d0 = 0; d0 < 8; ++d0) { const v4u raw = *(const v4u*)(pr + d0 * 16); float x[8]; unpack8(raw, x);
#pragma unroll
              for (int e = 0; e < 8; ++e) x[e] = s[d0][e] * inv - x[e];
              const v4u o = pack8(x); Bf[d0] = __builtin_bit_cast(att::bf16x8, o); } }
#pragma unroll
        for (int nb = 0; nb < 4; ++nb) {
            f32x16 acc = {};
            const bf16* wrow = PW + ((size_t)g * 128 + nb * 32 + r32) * 128 + hi * 8;
#pragma unroll
            for (int d0 = 0; d0 < 8; ++d0) { const att::bf16x8 a = *(const att::bf16x8*)(wrow + d0 * 16); acc = __builtin_amdgcn_mfma_f32_32x32x16_bf16(a, Bf[d0], acc, 0, 0, 0); }
#pragma unroll
            for (int q = 0; q < 4; ++q) { const int n0 = nb * 32 + 8 * q + 4 * hi; const f32x4 sc4 = *(const f32x4*)(ps + g * 128 + n0);
                u32x2v o; o.x = pkbf(acc[4 * q] * sc4[0], acc[4 * q + 1] * sc4[1]); o.y = pkbf(acc[4 * q + 2] * sc4[2], acc[4 * q + 3] * sc4[3]);
                *(u32x2v*)(MIX + (size_t)row * DM + g * 128 + n0) = o; }
        }
    }
}

__device__ __forceinline__ void conv_unit(const Args& A, int j, int unit) {
    LANE_VARS;
    const bf16* PROJ = (const bf16*)(A.ws + WS_PROJ); bf16* MIX = (bf16*)(A.ws + WS_MIX); const float* cw = A.in[27] + (size_t)j * 3 * 512;
    for (int idx = tid_; idx < 64 * 64; idx += NWAVES * 64) {
        const int row = unit * 64 + (idx >> 6), ch = (idx & 63) * 8;
        int L, t; if (row < NCTX) { L = 256; t = row & 255; } else { L = 2048; t = (row - NCTX) & 2047; }
        const bf16* pr = PROJ + (size_t)row * CD_IN + ch;
        float xi[8], gc[8], gb[8], u0[8], u1[8], u2[8];
        unpack8(*(const v4u*)(pr + 4608), xi); unpack8(*(const v4u*)(pr + 5632), gc); unpack8(*(const v4u*)(pr + 5120), gb);
#pragma unroll
        for (int e = 0; e < 8; ++e) u1[e] = gc[e] * xi[e];
        if (t > 0) { unpack8(*(const v4u*)(pr - CD_IN + 4608), xi); unpack8(*(const v4u*)(pr - CD_IN + 5632), gc);
#pragma unroll
            for (int e = 0; e < 8; ++e) u0[e] = gc[e] * xi[e]; }
        else {
#pragma unroll
            for (int e = 0; e < 8; ++e) u0[e] = 0.f; }
        if (t < L - 1) { unpack8(*(const v4u*)(pr + CD_IN + 4608), xi); unpack8(*(const v4u*)(pr + CD_IN + 5632), gc);
#pragma unroll
            for (int e = 0; e < 8; ++e) u2[e] = gc[e] * xi[e]; }
        else {
#pragma unroll
            for (int e = 0; e < 8; ++e) u2[e] = 0.f; }
        const f32x4 w0a = *(const f32x4*)(cw + ch), w0b = *(const f32x4*)(cw + ch + 4), w1a = *(const f32x4*)(cw + 512 + ch), w1b = *(const f32x4*)(cw + 512 + ch + 4), w2a = *(const f32x4*)(cw + 1024 + ch), w2b = *(const f32x4*)(cw + 1024 + ch + 4);
        float y[8];
#pragma unroll
        for (int e = 0; e < 4; ++e) { y[e] = gb[e] * (w0a[e] * u0[e] + w1a[e] * u1[e] + w2a[e] * u2[e]); y[4 + e] = gb[4 + e] * (w0b[e] * u0[4 + e] + w1b[e] * u1[4 + e] + w2b[e] * u2[4 + e]); }
        *(v4u*)(MIX + (size_t)row * DM + 1536 + ch) = pack8(y);
    }
}

__device__ __forceinline__ void attn_phase(Frame& F, const Args& A, int qslot, int layer, int j, bool even) {
    LANE_VARS;
    const bf16* PROJ = (const bf16*)(A.ws + WS_PROJ); bf16* MIX = (bf16*)(A.ws + WS_MIX);
    gu32* ctr = F.ctl + CW_Q + 64 * qslot;
    const int ldq = even ? AB_IN : CD_IN, qcol0 = even ? 512 : 0, kcol0 = even ? 2048 : 1536, vcol0 = even ? 2560 : 3072, mixcol0 = even ? 512 : 0, ldl = even ? 512 : 1536;
    const bf16* KL = even ? (const bf16*)(A.ws + WS_KLAB) + (size_t)j * 2 * LKV * 512 : (const bf16*)(A.ws + WS_KLCD) + (size_t)j * 2 * LKV * 1536;
    const bf16* VL = even ? (const bf16*)(A.ws + WS_VLAB) + (size_t)j * 2 * LKV * 512 : (const bf16*)(A.ws + WS_VLCD) + (size_t)j * 2 * LKV * 1536;
    const float* rpb = A.in[26] + (size_t)j * 12 * 465;
    const float* qgain = A.in[22] + j * 128; const float* ROPE = (const float*)(A.ws + WS_ROPE);
    constexpr int NLONG = 2 * 12 * 8, NATT = NLONG + 32 * 12, NUNITS = NATT + MTOK / 64;
    for (;;) {
        if (tid_ == 0) F.MISC[0] = __hip_atomic_fetch_add(ctr, 1u, __ATOMIC_RELAXED, __HIP_MEMORY_SCOPE_AGENT);
        __syncthreads();
        const int u = (int)F.MISC[0];
        __syncthreads();
        if (u >= NUNITS) break;
        if (u >= NATT) { if (even) pool_unit(A, j, u - NATT); else conv_unit(A, j, u - NATT); continue; }
        att::AUnit U; U.qg = even ? qgain : nullptr; U.rope = nullptr; U.t0 = 0;
        if (u < NLONG) {
            const int b = u / 96, rem = u % 96, h = rem >> 3, qb = rem & 7, kvh = even ? h / 3 : h;
            const size_t row0 = (size_t)NCTX + b * LSEQ + qb * 256;
            U.Q = PROJ + row0 * ldq + qcol0 + h * 128; U.ldq = ldq;
            U.K = KL + (size_t)b * LKV * ldl + kvh * 128; U.V = VL + (size_t)b * LKV * ldl + kvh * 128; U.ldk = ldl;
            U.O = MIX + row0 * DM + mixcol0 + h * 128; U.ldo = DM; U.rpb = rpb + h * 465;
            if (even) { U.ntiles = LKV / 64; U.nband = 0; U.band0 = 0; U.ctx0 = 0; U.qrow0 = 0; U.rope = ROPE; U.t0 = qb * 256; }
            else { const int b0 = min(max(4 * qb - 4, 0), 24), last = min(max(4 * qb - 1, 0), 24) + 7;
                U.nband = last - b0 + 1; U.band0 = b0; U.ctx0 = LSEQ; U.ntiles = U.nband + PAST / 64; U.qrow0 = 4 * qb; }
        } else {
            const int v = u - NLONG, b = v / 12, h = v % 12, kvh = even ? h / 3 : h;
            const size_t row0 = (size_t)b * 256;
            U.Q = PROJ + row0 * ldq + qcol0 + h * 128; U.ldq = ldq;
            U.K = PROJ + row0 * ldq + kcol0 + kvh * 128; U.V = PROJ + row0 * ldq + vcol0 + kvh * 128; U.ldk = ldq;
            U.O = MIX + row0 * DM + mixcol0 + h * 128; U.ldo = DM; U.rpb = rpb;
            U.ntiles = 4; U.nband = 0; U.band0 = 0; U.ctx0 = 0; U.qrow0 = 0;
        }
        if (U.nband == 0 && U.ntiles >= 8) att::attn_unit_dense(U, F.ldsg); else att::attn_unit(U, F.ldsg);
    }
}

#ifndef STAGGER_US
#define STAGGER_US 0
#endif
__device__ __forceinline__ void stagger_delay(int c) { if (STAGGER_US > 0 && ((c >> 3) & 1)) { const unsigned long long t0 = __builtin_amdgcn_s_memrealtime(); while (__builtin_amdgcn_s_memrealtime() - t0 < 100ull * STAGGER_US) __builtin_amdgcn_s_sleep(8); } }
#ifndef DOWN_KS
#define DOWN_KS 2
#endif
#ifndef PROBE_DUP
#define PROBE_DUP 0
#endif
#define NREP(mask) (((PROBE_DUP) & (mask)) ? 2 : 1)
#define IN(k) (lo <= (k) && (k) < hi)
#define SEAM(k) do { if (IN(k) && IN((k) + 1)) { xcd_barrier(bar); if ((PROBE_DUP) & 512) xcd_barrier(bar); } } while (0)
template <int I>
__device__ __forceinline__ void run_layer(Frame& F, const Args& args, const XcdBarrier& bar, const int lo, const int hi) {
    constexpr int pb = 2 + 8 * I, j = I >> 1; constexpr bool even = !(I & 1);
    unsigned char* ws = args.ws;
    bf16* H = (bf16*)(ws + WS_H); bf16* PROJ = (bf16*)(ws + WS_PROJ); bf16* MIX = (bf16*)(ws + WS_MIX);
    bf16* D1 = (bf16*)(ws + WS_Y); bf16* D2 = (bf16*)(ws + WS_Y2); bf16* X = (bf16*)(ws + WS_X); float* MOD = (float*)(ws + WS_MOD);
    const float* modl = MOD + (size_t)I * 3 * 12288;
    if (IN(pb + 0)) {
        constexpr int N = even ? AB_IN : CD_IN;
        const bf16* Wt = even ? (const bf16*)(ws + WS_WINAB) + (size_t)j * AB_IN * DM : (const bf16*)(ws + WS_WINCD) + (size_t)j * CD_IN * DM;
        int geff, c, nside; const bool is_gemm = split_roles(F, (MTOK / 256) * (N / 256), true, geff, c, nside);
        pg8::Gemm g{H, Wt, MTOK, N, DM, DM}; pg8::StaticOrder S; S.init(MTOK, N, geff, c);
        pg8::EpiProj E;
        E.O = PROJ; E.ldc = N;
        if (even) { E.lo = 2560; E.mid = 3072; E.hi = 3072; E.R0 = (bf16*)(ws + WS_VLAB) + (size_t)j * 2 * LKV * 512; E.R1 = E.R0; E.rld = 512; E.F0 = args.out + out_v_off(I); E.F1 = E.F0; }
        else { E.lo = 1536; E.mid = 3072; E.hi = 4608; E.R0 = (bf16*)(ws + WS_KLCD) + (size_t)j * 2 * LKV * 1536; E.R1 = (bf16*)(ws + WS_VLCD) + (size_t)j * 2 * LKV * 1536; E.rld = 1536;
            E.F0 = args.out + out_k_off(I); E.F1 = args.out + out_v_off(I); }
        if constexpr (SIDE_MODE == 1) prefix_work<I + 1, 0>(F, args, (MTOK / 256) * (N / 256));
        if (is_gemm) { stagger_delay(c); for (int rep = 0; rep < NREP(1); ++rep) pg8::gemm_phase<pg8::EpiProj, pg8::StaticOrder, true, true>(F.lds + RING_OFF, g, S, E); }
        if constexpr (SIDE_MODE == 0) { if (!is_gemm) side_work<I + 1, 0>(F, args, c, nside); else if (nside == 0) side_work<I + 1, 0>(F, args, c, geff); }
    }
    SEAM(pb + 0);
    if (even) { if (IN(pb + 1)) prep_ab(F, args, I, j); SEAM(pb + 1); }
    if (IN(pb + 2)) { for (int rep = 0; rep < NREP(2); ++rep) attn_phase(F, args, I + 4 * rep, I, j, even); }
    SEAM(pb + 2);
    if (IN(pb + 3)) {
        const bf16* Wt = even ? (const bf16*)(ws + WS_WOUTAB) + (size_t)j * DM * DM : (const bf16*)(ws + WS_WOUTCD) + (size_t)j * DM * DM;
        int geff, c, nside; const bool is_gemm = split_roles(F, (MTOK / 256) * (DM / 256), I < 3, geff, c, nside);
        pg8::Gemm g{MIX, Wt, MTOK, DM, DM, DM}; pg8::StaticOrder S; S.init(MTOK, DM, geff, c);
        pg8::EpiD E{D1, D1, modl + 4096};
        if constexpr (I < 3 && SIDE_MODE == 1) prefix_work<I + 1, 1>(F, args, (MTOK / 256) * (DM / 256));
        if (is_gemm) { stagger_delay(c); for (int rep = 0; rep < NREP(4); ++rep) pg8::gemm_phase<pg8::EpiD, pg8::StaticOrder, true, true>(F.lds + RING_OFF, g, S, E); }
        if constexpr (I < 3 && SIDE_MODE == 0) { if (!is_gemm) side_work<I + 1, 1>(F, args, c, nside); else if (nside == 0) side_work<I + 1, 1>(F, args, c, geff); }
    }
    SEAM(pb + 3);
    if (IN(pb + 4)) { for (int rep = 0; rep < NREP(16); ++rep) if (I == 0) ln_phase<true, false>(F, args.in[0], args.in[1], D1, nullptr, X, args.in[14] + I * DM, args.in[15] + I * DM, modl + 6144, H); else ln_phase<false, false>(F, X, X + (size_t)NCTX * DM, D1, nullptr, X, args.in[14] + I * DM, args.in[15] + I * DM, modl + 6144, H); }
    SEAM(pb + 4);
    if (IN(pb + 5)) {
        pg8::Gemm g{H, (const bf16*)(ws + WS_WGU) + (size_t)I * NGU * DM, MTOK, NGU, DM, DM};
        int geff, c, nside; const bool is_gemm = split_roles(F, (MTOK / 256) * (NGU / 256), I < 3, geff, c, nside); pg8::StaticOrder S; S.init(MTOK, NGU, geff, c);
        pg8::EpiGU E{PROJ};
        if constexpr (I < 3 && SIDE_MODE == 1) prefix_work<I + 1, 2>(F, args, (MTOK / 256) * (NGU / 256));
        if (is_gemm) { stagger_delay(c); for (int rep = 0; rep < NREP(8); ++rep) pg8::gemm_phase<pg8::EpiGU, pg8::StaticOrder, true, true>(F.lds + RING_OFF, g, S, E); }
        if constexpr (I < 3 && SIDE_MODE == 0) { if (!is_gemm) side_work<I + 1, 2>(F, args, c, nside); else if (nside == 0) side_work<I + 1, 2>(F, args, c, geff); }
    }
    SEAM(pb + 5);
    if (IN(pb + 6)) {
        pg8::Gemm g{PROJ, (const bf16*)(ws + WS_WDN) + (size_t)I * DM * FFH, MTOK, DM, FFH / DOWN_KS, FFH}; pg8::StaticOrder S; S.init(MTOK, DM, F.G, (int)blockIdx.x, DOWN_KS, FFH / DOWN_KS);
        pg8::EpiD E{D1, D2, modl + 10240};
        stagger_delay((int)blockIdx.x);
        for (int rep = 0; rep < NREP(4); ++rep) pg8::gemm_phase<pg8::EpiD, pg8::StaticOrder, true, true>(F.lds + RING_OFF, g, S, E);
    }
    SEAM(pb + 6);
    if (IN(pb + 7)) {
        if (I < 3) { for (int rep = 0; rep < NREP(16); ++rep) ln_phase<false, false>(F, X, X + (size_t)NCTX * DM, D1, DOWN_KS > 1 ? D2 : nullptr, X, args.in[16] + I * DM, args.in[17] + I * DM, modl + 3 * 12288, H); }
        else ln_phase<false, true>(F, X, X + (size_t)NCTX * DM, D1, DOWN_KS > 1 ? D2 : nullptr, args.out, args.in[16] + I * DM, args.in[17] + I * DM, nullptr, H);
    }
    if (I < 3) SEAM(pb + 7);
}

__global__ void __launch_bounds__(NWAVES * 64, 2) mk_fwd(Args args) {
    extern __shared__ __attribute__((aligned(16))) unsigned char lds[];
    Frame F;
    F.lds = (LAS unsigned char*)lds; F.ldsg = (char*)lds;
    F.MISC = (volatile LAS unsigned*)(F.lds + MISC_OFF);
    F.G = gridDim.x; { const int bx = blockIdx.x; F.vcu = (F.G % 8 == 0) ? (bx % 8) * (F.G / 8) + bx / 8 : bx; }
    F.ctl = (gu32*)(args.ws + WS_CTL);
    for (int u = threadIdx.x; u < (LDS_BYTES - LDSCTL_OFF) / 4; u += NWAVES * 64) ((LAS unsigned*)(F.lds + LDSCTL_OFF))[u] = 0u;
    __syncthreads();
    const int lo = args.ph_lo, hi = args.ph_hi;
    XcdBarrier bar; bar.bar = (unsigned*)(F.ctl + CW_BAR); bar.x = 0; bar.st = nullptr;
    if (hi - lo > 1) bar = xcd_barrier_post((unsigned*)(F.ctl + CW_BAR), F.MISC + 8);

    if (IN(0)) { for (int rep = 0; rep < NREP(32); ++rep) p0_prologue(F, args); }
    SEAM(0);
    if (IN(1)) { for (int rep = 0; rep < NREP(32); ++rep) p1_modulate_x(F, args); }
    SEAM(1);
    run_layer<0>(F, args, bar, lo, hi);
    run_layer<1>(F, args, bar, lo, hi);
    run_layer<2>(F, args, bar, lo, hi);
    run_layer<3>(F, args, bar, lo, hi);
}
#undef IN
#undef SEAM

extern "C" void kernel_launch(void* const* d_in, const int* in_sizes, int n_in, void* d_out, int out_size, void* d_ws, size_t ws_size, hipStream_t stream) {
    static int grid = 0;
    if (grid == 0) {
        if (n_in != 31 || (size_t)out_size != OUT_TOTAL || ws_size < WS_END) { fprintf(stderr, "kernel_launch: unexpected shapes: n_in %d out %d ws %zu (need %zu)\n", n_in, out_size, ws_size, (size_t)WS_END); grid = -1; return; }
        int dev = 0, cus = 0, per_cu = 0;
        if (hipGetDevice(&dev) != hipSuccess || hipDeviceGetAttribute(&cus, hipDeviceAttributeMultiprocessorCount, dev) != hipSuccess) { grid = -1; return; }
        if (hipFuncSetAttribute((const void*)mk_fwd, hipFuncAttributeMaxDynamicSharedMemorySize, LDS_BYTES) != hipSuccess) { fprintf(stderr, "kernel_launch: hipFuncSetAttribute failed\n"); grid = -1; return; }
        if (hipOccupancyMaxActiveBlocksPerMultiprocessor(&per_cu, (const void*)mk_fwd, NWAVES * 64, LDS_BYTES) != hipSuccess || per_cu < 1) fprintf(stderr, "kernel_launch: occupancy query reports %d\n", per_cu);
        (void)hipGetLastError();
        grid = cus;
    }
    if (grid < 0) return;
    if (hipMemsetAsync((char*)d_ws + WS_CTL, 0, CTL_ZERO_BYTES, stream) != hipSuccess) return;
    Args a{};
    for (int i = 0; i < 31; ++i) a.in[i] = (const float*)d_in[i];
    a.out = (float*)d_out; a.ws = (unsigned char*)d_ws;
#if MK_PER_PHASE
    for (int p = 0; p < NPHASES; ++p) { a.ph_lo = p; a.ph_hi = p + 1; hipLaunchKernelGGL(mk_fwd, dim3(grid), dim3(NWAVES * 64), LDS_BYTES, stream, a); }
#else
    a.ph_lo = 0; a.ph_hi = NPHASES; hipLaunchKernelGGL(mk_fwd, dim3(grid), dim3(NWAVES * 64), LDS_BYTES, stream, a);
#endif
    const hipError_t le = hipPeekAtLastError();
    if (le != hipSuccess) fprintf(stderr, "kernel_launch: launch failed: %s\n", hipGetErrorName(le));
}
```
